# Optimizing an MI355X kernel written in HIP

```python
import jax, jax.numpy as jnp
from jax import lax
import numpy as np

D_MODEL = 4096
BATCH = 1
SEQ = 8192
DEPTH = 1

CHUNK = 64
Q_BLOCK = 128

D_MIX = D_MODEL
GLA_WIDTH = D_MIX // 2
GLA_HEADS = 16
GLA_DV = GLA_WIDTH // GLA_HEADS
GLA_DK = GLA_DV // 2
GLA_GATE_RANK = 16
GLA_GATE_TAU = 16.0

MLA_WIDTH = D_MIX - GLA_WIDTH
MLA_HEADS = 16
MLA_DV = MLA_WIDTH // MLA_HEADS
MLA_DN = 128
MLA_DR = 64
MLA_Q_RANK = 1536
MLA_KV_RANK = 512
ROPE_THETA = 10000.0

IN_SPLITS = (
    GLA_HEADS * GLA_DK,
    GLA_HEADS * GLA_DK,
    GLA_WIDTH,
    GLA_GATE_RANK,
    GLA_WIDTH,
    MLA_Q_RANK,
    MLA_KV_RANK,
    MLA_DR,
    MLA_WIDTH,
)
IN_WIDTH = sum(IN_SPLITS)

EPS = 1e-6

kernel_name = "hybrid_gla_mla_adaln_sandwich"


def rms_norm(t, g):
    tf = t.astype(jnp.float32)
    y = tf * lax.rsqrt(jnp.mean(tf * tf, axis=-1, keepdims=True) + EPS)
    return (y * g.astype(jnp.float32)).astype(t.dtype)


def apply_rope(t, cos, sin):
    tf = t.astype(jnp.float32)
    t1, t2 = jnp.split(tf, 2, axis=-1)
    return jnp.concatenate([t1 * cos - t2 * sin, t2 * cos + t1 * sin], axis=-1).astype(t.dtype)


def gla_chunk_causal(q, k, v, log_a):
    B, S, H, DK = q.shape
    DV = v.shape[-1]
    N = S // CHUNK
    f32 = jnp.float32
    qc = q.reshape(B, N, CHUNK, H, DK).astype(f32)
    kc = k.reshape(B, N, CHUNK, H, DK).astype(f32)
    vc = v.reshape(B, N, CHUNK, H, DV).astype(f32)
    la = log_a.reshape(B, N, CHUNK, H, DK).astype(f32)
    lcum = jnp.cumsum(la, axis=2)
    ltot = lcum[:, :, -1]
    k_dec = kc * jnp.exp(ltot[:, :, None] - lcum)
    q_dec = qc * jnp.exp(ltot)[:, :, None]
    scores = jnp.einsum('bnchd,bnshd->bnhcs', qc, k_dec)
    o_intra = jnp.einsum('bnhcs,bnshv->bnchv', scores, vc)
    kv = jnp.einsum('bnshd,bnshv->bnhdv', k_dec, vc)

    def step(state, inp):
        decay, kv_n = inp
        return decay[..., None] * state + kv_n, state

    s0 = jnp.zeros((B, H, DK, DV), f32)
    _, s_before = lax.scan(step, s0, (jnp.exp(ltot).swapaxes(0, 1), kv.swapaxes(0, 1)))
    s_before = s_before.swapaxes(0, 1)
    o_inter = jnp.einsum('bnchd,bnhdv->bnchv', q_dec, s_before)
    return (o_intra + o_inter).reshape(B, S, H, DV).astype(v.dtype)


def mla_chunk_causal(q_nope, q_rope, k_nope, k_rope, v):
    B, S, H, DN = q_nope.shape
    DR = q_rope.shape[-1]
    nb = S // Q_BLOCK
    scale = (DN + DR) ** -0.5
    key_chunk = jnp.arange(S) // CHUNK

    def block(args):
        qn, qr, i = args
        s = (jnp.einsum('bqhd,bkhd->bhqk', qn, k_nope)
             + jnp.einsum('bqhr,bkr->bhqk', qr, k_rope)).astype(jnp.float32) * scale
        q_chunk = (i * Q_BLOCK + jnp.arange(Q_BLOCK)) // CHUNK
        mask = key_chunk[None, :] <= q_chunk[:, None]
        s = jnp.where(mask[None, None], s, -jnp.inf)
        p = jax.nn.softmax(s, axis=-1).astype(v.dtype)
        return jnp.einsum('bhqk,bkhv->bqhv', p, v)

    qn_b = q_nope.reshape(B, nb, Q_BLOCK, H, DN).swapaxes(0, 1)
    qr_b = q_rope.reshape(B, nb, Q_BLOCK, H, DR).swapaxes(0, 1)
    out = lax.map(block, (qn_b, qr_b, jnp.arange(nb)))
    return out.swapaxes(0, 1).reshape(B, S, H, v.shape[-1])


def setup_inputs(seed: int = 0) -> dict:
    key = jax.random.key(seed)
    ks = jax.random.split(key, 20)
    f32 = jnp.float32
    nrm = lambda k, shape, s: jax.random.normal(k, shape, f32) * s
    x = nrm(ks[0], (BATCH, SEQ, D_MODEL), 1.0)
    c = nrm(ks[1], (BATCH, D_MODEL), 1.0)
    offset = jax.random.randint(ks[2], (BATCH, 1), 0, 4096, dtype=jnp.int32)
    positions = (offset + jnp.arange(SEQ, dtype=jnp.int32)[None, :]).astype(jnp.int32)
    w_ada = nrm(ks[3], (D_MODEL, 3 * D_MODEL), 0.5 * D_MODEL ** -0.5)
    b_ada = nrm(ks[4], (3 * D_MODEL,), 0.01)
    g_pre = 1.0 + nrm(ks[5], (D_MODEL,), 0.02)
    g_post = 1.0 + nrm(ks[6], (D_MODEL,), 0.02)
    w_in = nrm(ks[7], (D_MODEL, IN_WIDTH), D_MODEL ** -0.5)
    w_alpha_up = nrm(ks[8], (GLA_GATE_RANK, GLA_HEADS * GLA_DK), GLA_GATE_RANK ** -0.5)
    b_alpha = nrm(ks[9], (GLA_HEADS * GLA_DK,), 0.1)
    g_gla_out = 1.0 + nrm(ks[10], (GLA_DV,), 0.02)
    g_q_norm = 1.0 + nrm(ks[11], (MLA_Q_RANK,), 0.02)
    w_uq = nrm(ks[12], (MLA_Q_RANK, MLA_HEADS * (MLA_DN + MLA_DR)), MLA_Q_RANK ** -0.5)
    g_kv_norm = 1.0 + nrm(ks[13], (MLA_KV_RANK,), 0.02)
    w_ukv = nrm(ks[14], (MLA_KV_RANK, MLA_HEADS * (MLA_DN + MLA_DV)), MLA_KV_RANK ** -0.5)
    w_out = nrm(ks[15], (D_MIX, D_MODEL), D_MIX ** -0.5)
    return {"x": x, "c": c, "positions": positions, "w_ada": w_ada, "b_ada": b_ada,
            "g_pre": g_pre, "g_post": g_post, "w_in": w_in, "w_alpha_up": w_alpha_up,
            "b_alpha": b_alpha, "g_gla_out": g_gla_out, "g_q_norm": g_q_norm, "w_uq": w_uq,
            "g_kv_norm": g_kv_norm, "w_ukv": w_ukv, "w_out": w_out}


def reference(x, c, positions, w_ada, b_ada, g_pre, g_post, w_in, w_alpha_up, b_alpha,
              g_gla_out, g_q_norm, w_uq, g_kv_norm, w_ukv, w_out):
    B, S, D = x.shape
    half = MLA_DR // 2
    inv_freq = ROPE_THETA ** (-jnp.arange(half, dtype=jnp.float32) / half)
    ang = positions.astype(jnp.float32)[..., None] * inv_freq
    cos, sin = jnp.cos(ang), jnp.sin(ang)
    offsets = [int(o) for o in np.cumsum(IN_SPLITS)[:-1]]

    for _ in range(DEPTH):
        mod = jax.nn.silu(c) @ w_ada + b_ada
        shift, scale, gate = jnp.split(mod, 3, axis=-1)
        h = rms_norm(x, g_pre) * (1.0 + scale[:, None]) + shift[:, None]

        proj = h @ w_in
        (g_q, g_k, g_v, g_alr, g_gate,
         m_cq, m_ckv, m_kr, m_gate) = jnp.split(proj, offsets, axis=-1)

        q_a = g_q.reshape(B, S, GLA_HEADS, GLA_DK) * (GLA_DK ** -0.5)
        k_a = g_k.reshape(B, S, GLA_HEADS, GLA_DK)
        v_a = g_v.reshape(B, S, GLA_HEADS, GLA_DV)
        log_a = jax.nn.log_sigmoid((g_alr @ w_alpha_up + b_alpha).astype(jnp.float32)) / GLA_GATE_TAU
        log_a = log_a.reshape(B, S, GLA_HEADS, GLA_DK)
        o_a = gla_chunk_causal(q_a, k_a, v_a, log_a)
        o_a = rms_norm(o_a, g_gla_out).reshape(B, S, GLA_WIDTH) * jax.nn.silu(g_gate)

        q_b = (rms_norm(m_cq, g_q_norm) @ w_uq).reshape(B, S, MLA_HEADS, MLA_DN + MLA_DR)
        q_nope, q_rope = q_b[..., :MLA_DN], q_b[..., MLA_DN:]
        q_rope = apply_rope(q_rope, cos[:, :, None, :], sin[:, :, None, :])
        kv_b = (rms_norm(m_ckv, g_kv_norm) @ w_ukv).reshape(B, S, MLA_HEADS, MLA_DN + MLA_DV)
        k_nope, v_b = kv_b[..., :MLA_DN], kv_b[..., MLA_DN:]
        k_rope = apply_rope(m_kr, cos, sin)
        o_b = mla_chunk_causal(q_nope, q_rope, k_nope, k_rope, v_b)
        o_b = o_b.reshape(B, S, MLA_WIDTH) * jax.nn.silu(m_gate)

        mix = jnp.concatenate([o_a, o_b], axis=-1) @ w_out
        x = x + gate[:, None] * rms_norm(mix, g_post)
    return x
```

```cpp
#include <hip/hip_runtime.h>
#include <cstdio>
#include <cstdint>

typedef unsigned short bf16_t;
typedef short bf16x8 __attribute__((ext_vector_type(8)));
typedef float f32x4 __attribute__((ext_vector_type(4)));
typedef float f32x2 __attribute__((ext_vector_type(2)));
typedef unsigned u32x4 __attribute__((ext_vector_type(4)));
typedef unsigned u32x2 __attribute__((ext_vector_type(2)));

constexpr int S = 8192, DM = 4096, NT = 512, NWAVES = 8;
constexpr int IN_WIDTH = 10320, NPROJ = 10240, NTHIN = 80;
constexpr int PC_GQ = 0, PC_GK = 1024, PC_GV = 2048, PC_GGATE = 4096, PC_MCQ = 6144, PC_MCKV = 7680, PC_MGATE = 8192;
constexpr int NQ = 3072, NKV = 4096, QRANK = 1536, KVRANK = 512;
constexpr int NCH = 128, GH = 16;
constexpr float EPS = 1e-6f;
constexpr float C2 = 0.07216878364870322f * 1.4426950408889634f;

constexpr size_t MiB = 1u << 20;
constexpr size_t WS_CTL = 0, CTL_ZERO_BYTES = 256 * 1024, WS_MODP = 1 * MiB, WS_ROPE = 2 * MiB, WS_SSQQ = 4 * MiB, WS_SSQKV = 5 * MiB, WS_SSQMIX = 6 * MiB, WS_DECAY = 8 * MiB, WS_THIN = 9 * MiB,
                 WS_KR = 12 * MiB, WS_WTALL = 16 * MiB, WS_WTUQ = 97 * MiB, WS_WTUKV = 106 * MiB, WS_WTOUT = 110 * MiB, WS_H = 142 * MiB, WS_PROJ = 206 * MiB,
                 WS_Q = 366 * MiB, WS_KV = 414 * MiB, WS_KVN = 478 * MiB, WS_SN = 542 * MiB, WS_MIXIN = 574 * MiB, WS_MIX = 142 * MiB  , WS_END = 638 * MiB;
constexpr int CW_BAR = 4096;

__device__ __forceinline__ float bf2f(bf16_t b) { return __uint_as_float((unsigned)b << 16); }
__device__ __forceinline__ unsigned f2bf(float f) { unsigned u = __float_as_uint(f); return (u + 0x7fffu + ((u >> 16) & 1u)) >> 16; }
__device__ __forceinline__ unsigned pk2(float lo, float hi) { return f2bf(lo) | (f2bf(hi) << 16); }
__device__ __forceinline__ float silu_f(float x) { return x / (1.f + __expf(-x)); }
__device__ __forceinline__ float wave_sum(float v) {
#pragma unroll
    for (int o = 1; o < 64; o <<= 1) v += __shfl_xor(v, o);
    return v;
}

namespace pg8 {
#define PG8_LAS __attribute__((address_space(3)))
constexpr int BM = 256, BK = 64, HALF = 128, HTB = HALF * BK * 2  , STAGE_BYTES = 8 * HTB, NXCD = 8, WGM = 8;

__host__ __device__ __forceinline__ int lds_byte(int r, int c) { const int st = (r >> 4) * 2 + (c >> 5), rr = r & 15, cc = c & 31, ob = rr * 64 + cc * 2; return st * 1024 + (ob ^ (((ob >> 9) & 1) << 5)); }
__host__ __device__ __forceinline__ void stage_rc(int b, int& R, int& C) { const int st = b / 1024, sb = b % 1024, swz = sb ^ (((sb >> 9) & 1) << 5); R = (st >> 1) * 16 + swz / 64; C = (st & 1) * 32 + (swz % 64) / 2; }
__host__ __device__ __forceinline__ int perm32(int rho) { const int n = rho >> 4, i = rho & 15; return 8 * (i >> 2) + 4 * n + (i & 3); }

struct Unit { int pm, pn; };
struct Gemm { const bf16_t* A; const bf16_t* Bt; int M, N, K, lda; };

struct StaticOrder {
    int nM, nN, nwg, G, c;
    __host__ __device__ void init(int M, int N, int G_, int c_) { nM = M / BM; nN = N / BM; nwg = nM * nN; G = G_; c = c_; }
    __host__ __device__ bool next(int i, Unit& u) const {
        const long L = (long)i * G + c; if (L >= nwg) return false;
        int wgid = (int)L; { const int q = nwg / NXCD, r = nwg % NXCD, xcd = wgid % NXCD, off = wgid / NXCD; wgid = (xcd < r ? xcd * (q + 1) : r * (q + 1) + (xcd - r) * q) + off; }
        const int nig = WGM * nN, gid = wgid / nig, fm = gid * WGM, gsz = (nM - fm) < WGM ? (nM - fm) : WGM;
        u.pm = fm + ((wgid % nig) % gsz); u.pn = (wgid % nig) / gsz; return true;
    }
    __device__ __forceinline__ void a_ready(const Unit&) const {}
    __device__ __forceinline__ void done(const Unit&) const {}
};

struct SplitOrderQ {
    int x, j, ok;
    __host__ __device__ void init(int v, int G) { x = v >> 5; j = v & 31; ok = (G == 256); }
    __host__ __device__ bool next(int i, Unit& u) const {
        if (!ok) return false;
        int idx; if (j < 16) { if (i > 1) return false; idx = 2 * j + i; } else { if (i > 0) return false; idx = 32 + (j - 16); }
        u.pm = 4 * x + idx / 12; u.pn = idx % 12; return true; }
    __device__ __forceinline__ void a_ready(const Unit&) const {}
    __device__ __forceinline__ void done(const Unit&) const {}
};
struct SplitOrderKV {
    int x, j, ok;
    __host__ __device__ void init(int v, int G) { x = v >> 5; j = v & 31; ok = (G == 256); }
    __host__ __device__ bool next(int i, Unit& u) const {
        if (!ok) return false;
        int idx; if (j < 16) { if (i > 0) return false; idx = j; } else { if (i > 2) return false; idx = 16 + 3 * (j - 16) + i; }
        u.pm = 4 * x + (idx >> 4); u.pn = idx & 15; return true; }
    __device__ __forceinline__ void a_ready(const Unit&) const {}
    __device__ __forceinline__ void done(const Unit&) const {}
};

typedef float f32x2_t __attribute__((ext_vector_type(2))); typedef __bf16 bf16x2_t __attribute__((ext_vector_type(2)));
__device__ __forceinline__ unsigned cvt_pk_bf16(float lo, float hi) { f32x2_t v = {lo, hi}; bf16x2_t b = __builtin_convertvector(v, bf16x2_t); return __builtin_bit_cast(unsigned, b); }
__device__ __forceinline__ u32x4 pack8v(f32x4 v0, f32x4 v1) { u32x4 w; w.x = cvt_pk_bf16(v0[0], v0[1]); w.y = cvt_pk_bf16(v0[2], v0[3]); w.z = cvt_pk_bf16(v1[0], v1[1]); w.w = cvt_pk_bf16(v1[2], v1[3]); return w; }
__device__ __forceinline__ float sumsq8(f32x4 a, f32x4 b) { return (a[0] * a[0] + a[1] * a[1]) + (a[2] * a[2] + a[3] * a[3]) + (b[0] * b[0] + b[1] * b[1]) + (b[2] * b[2] + b[3] * b[3]); }

struct EpiProjF {
    static constexpr bool PERM = true, AFTER_DRAIN = false;
    bf16_t* O; float* SSQQ; float* SSQKV;
    __device__ __forceinline__ void operator()(const f32x4 (&acc)[2][2][4][2], const Unit& u, int wr, int wc, int fr, int fq) const {
        const int row0 = u.pm * BM + wr * 64 + fr, col0 = u.pn * BM + wc * 32 + 8 * fq;
        const bool sq = u.pn >= 24 && u.pn < 32;
#pragma unroll
        for (int ai = 0; ai < 2; ++ai)
#pragma unroll
            for (int m = 0; m < 4; ++m) { const int row = row0 + ai * HALF + m * 16; bf16_t* rowp = O + (size_t)row * NPROJ + col0;
#pragma unroll
                for (int bj = 0; bj < 2; ++bj) *(u32x4*)(rowp + bj * HALF) = pack8v(acc[ai][bj][m][0], acc[ai][bj][m][1]);
                if (sq) { float s = sumsq8(acc[ai][0][m][0], acc[ai][0][m][1]) + sumsq8(acc[ai][1][m][0], acc[ai][1][m][1]);
                    s += __shfl_xor(s, 16); s += __shfl_xor(s, 32);
                    if (fq == 0) { if (u.pn < 30) SSQQ[(size_t)row * 24 + (u.pn - 24) * 4 + wc] = s; else SSQKV[(size_t)row * 8 + (u.pn - 30) * 4 + wc] = s; } } }
    }
};
struct EpiQF {
    static constexpr bool PERM = true, AFTER_DRAIN = false;
    bf16_t* O; const float* SSQQ; const f32x2* ROPE;
    __device__ __forceinline__ void operator()(const f32x4 (&acc)[2][2][4][2], const Unit& u, int wr, int wc, int fr, int fq) const {
        const int row0 = u.pm * BM + wr * 64 + fr, col0 = u.pn * BM + wc * 32 + 8 * fq;
        const bool rope = u.pn >= 8;
#pragma unroll
        for (int ai = 0; ai < 2; ++ai)
#pragma unroll
            for (int m = 0; m < 4; ++m) { const int row = row0 + ai * HALF + m * 16;
                const f32x4* sp = (const f32x4*)(SSQQ + (size_t)row * 24); f32x4 t = sp[0];
#pragma unroll
                for (int i = 1; i < 6; ++i) t = t + sp[i];
                const float r = C2 / sqrtf(((t[0] + t[1]) + (t[2] + t[3])) * (1.f / QRANK) + EPS);
                bf16_t* rowp = O + (size_t)row * NQ + col0;
#pragma unroll
                for (int bj = 0; bj < 2; ++bj) { f32x4 v0 = acc[ai][bj][m][0] * r, v1 = acc[ai][bj][m][1] * r;
                    if (rope) { const int i0 = ((col0 + bj * HALF) & 63) >> 1; const f32x4* cp = (const f32x4*)(ROPE + (size_t)row * 32 + i0); const f32x4 c01 = cp[0], c23 = cp[1];
                        const f32x4 w0 = {v0[0] * c01[0] - v0[1] * c01[1], v0[1] * c01[0] + v0[0] * c01[1], v0[2] * c01[2] - v0[3] * c01[3], v0[3] * c01[2] + v0[2] * c01[3]};
                        const f32x4 w1 = {v1[0] * c23[0] - v1[1] * c23[1], v1[1] * c23[0] + v1[0] * c23[1], v1[2] * c23[2] - v1[3] * c23[3], v1[3] * c23[2] + v1[2] * c23[3]};
                        v0 = w0; v1 = w1; }
                    *(u32x4*)(rowp + bj * HALF) = pack8v(v0, v1); } }
    }
};
struct EpiKVF {
    static constexpr bool PERM = true, AFTER_DRAIN = false;
    bf16_t* O; const float* SSQKV;
    __device__ __forceinline__ void operator()(const f32x4 (&acc)[2][2][4][2], const Unit& u, int wr, int wc, int fr, int fq) const {
        const int row0 = u.pm * BM + wr * 64 + fr, col0 = u.pn * BM + wc * 32 + 8 * fq;
#pragma unroll
        for (int ai = 0; ai < 2; ++ai)
#pragma unroll
            for (int m = 0; m < 4; ++m) { const int row = row0 + ai * HALF + m * 16;
                const f32x4* sp = (const f32x4*)(SSQKV + (size_t)row * 8); const f32x4 t = sp[0] + sp[1];
                const float r = 1.0f / sqrtf(((t[0] + t[1]) + (t[2] + t[3])) * (1.f / KVRANK) + EPS);
                bf16_t* rowp = O + (size_t)row * NKV + col0;
#pragma unroll
                for (int bj = 0; bj < 2; ++bj) *(u32x4*)(rowp + bj * HALF) = pack8v(acc[ai][bj][m][0] * r, acc[ai][bj][m][1] * r); }
    }
};
struct EpiMixF {
    static constexpr bool PERM = true, AFTER_DRAIN = false;
    bf16_t* O; float* SSQMIX;
    __device__ __forceinline__ void operator()(const f32x4 (&acc)[2][2][4][2], const Unit& u, int wr, int wc, int fr, int fq) const {
        const int row0 = u.pm * BM + wr * 64 + fr, col0 = u.pn * BM + wc * 32 + 8 * fq;
#pragma unroll
        for (int ai = 0; ai < 2; ++ai)
#pragma unroll
            for (int m = 0; m < 4; ++m) { const int row = row0 + ai * HALF + m * 16; bf16_t* rowp = O + (size_t)row * DM + col0;
#pragma unroll
                for (int bj = 0; bj < 2; ++bj) *(u32x4*)(rowp + bj * HALF) = pack8v(acc[ai][bj][m][0], acc[ai][bj][m][1]);
                float s = sumsq8(acc[ai][0][m][0], acc[ai][0][m][1]) + sumsq8(acc[ai][1][m][0], acc[ai][1][m][1]);
                s += __shfl_xor(s, 16); s += __shfl_xor(s, 32);
                if (fq == 0) SSQMIX[(size_t)row * 64 + u.pn * 4 + wc] = s; }
    }
};

template <class Epi, class Sched, bool ALIGN_EPI = false, bool SP2 = false>
__device__ __forceinline__ void gemm_phase(PG8_LAS unsigned char* lds, const Gemm g, const Sched& S, const Epi& E) {
    const int tid = threadIdx.x, wid = __builtin_amdgcn_readfirstlane(tid >> 6), lane = tid & 63, wr = wid >> 2, wc = wid & 3, fr = lane & 15, fq = lane >> 4;
    const int K = g.K, nt = K / BK;
    unsigned voffA[2], voffB[2];
#pragma unroll
    for (int i = 0; i < 2; ++i) { int R, C; stage_rc(tid * 16 + i * 8192, R, C); const int Rb = Epi::PERM ? ((R & ~31) + perm32(R & 31)) : R;
        voffA[i] = (unsigned)(R * g.lda + C) * 2u; voffB[i] = (unsigned)(Rb * K + C) * 2u; }
    const size_t kstep = (size_t)(BK * 2);
    const size_t hstepA = (size_t)HALF * g.lda * 2, hstepB = (size_t)HALF * K * 2;
    const size_t tstepA = 2 * hstepA, tstepB = 2 * hstepB;
    const unsigned ldsw = (unsigned)wid * 1024u;
    const int aoff = lds_byte(wr * 64 + fr, fq * 8), boff = lds_byte(wc * 32 + fr, fq * 8);
#define PG8_SA(b, h) (((b) * 2 + (h)) * HTB)
#define PG8_SB(b, h) ((4 + (b) * 2 + (h)) * HTB)
#define PG8_STAGE(bufoff, gbase, voff) do { _Pragma("unroll") for (int _i = 0; _i < 2; ++_i) \
        __builtin_amdgcn_global_load_lds((const unsigned*)((const char*)(gbase) + (voff)[_i]), (PG8_LAS unsigned*)(lds + (bufoff) + ldsw + _i * 8192), 16, 0, 0); } while (0)
#define PG8_LDA(dst, b, h) do { _Pragma("unroll") for (int m = 0; m < 4; ++m) _Pragma("unroll") for (int k = 0; k < 2; ++k) dst[m][k] = *(const PG8_LAS bf16x8*)(lds + PG8_SA(b, h) + aoff + m * 2048 + k * 1024); } while (0)
#define PG8_LDB(dst, b, h) do { _Pragma("unroll") for (int n = 0; n < 2; ++n) _Pragma("unroll") for (int k = 0; k < 2; ++k) dst[n][k] = *(const PG8_LAS bf16x8*)(lds + PG8_SB(b, h) + boff + n * 2048 + k * 1024); } while (0)
#define PG8_MMA(ai, bj, At, Bt) do { __builtin_amdgcn_s_setprio(1); _Pragma("unroll") for (int m = 0; m < 4; ++m) _Pragma("unroll") for (int n = 0; n < 2; ++n) _Pragma("unroll") for (int k = 0; k < 2; ++k) \
        acc[ai][bj][m][n] = __builtin_amdgcn_mfma_f32_16x16x32_bf16(Bt[n][k], At[m][k], acc[ai][bj][m][n], 0, 0, 0); __builtin_amdgcn_s_setprio(0); } while (0)
#define PG8_WAIT_V(n) asm volatile("s_waitcnt vmcnt(" #n ")" ::: "memory")
#define PG8_WAIT_L(n) asm volatile("s_waitcnt lgkmcnt(" #n ")" ::: "memory")
#define PG8_BAR __builtin_amdgcn_s_barrier()
#define PG8_SCHED __builtin_amdgcn_sched_barrier(0)
    Unit cur, nxt; int ui = 0;
    if (!S.next(0, cur)) return;
    f32x4 acc[2][2][4][2];
#pragma unroll
    for (int a = 0; a < 2; ++a)
#pragma unroll
        for (int b = 0; b < 2; ++b)
#pragma unroll
            for (int m = 0; m < 4; ++m)
#pragma unroll
                for (int n = 0; n < 2; ++n) acc[a][b][m][n] = (f32x4){0.f, 0.f, 0.f, 0.f};
    bf16x8 At[4][2], B0[2][2], B1[2][2];
    const char* cA = (const char*)g.A + (size_t)cur.pm * tstepA; const char* cB = (const char*)g.Bt + (size_t)cur.pn * tstepB;
    S.a_ready(cur);
    if constexpr (SP2) {
        PG8_STAGE(PG8_SB(0, 0), cB, voffB); PG8_STAGE(PG8_SB(0, 1), cB + hstepB, voffB); PG8_STAGE(PG8_SA(0, 0), cA, voffA); PG8_STAGE(PG8_SA(0, 1), cA + hstepA, voffA);
        if (wr == 1) PG8_BAR;
        PG8_WAIT_V(2); PG8_BAR;
        PG8_STAGE(PG8_SB(1, 0), cB + kstep, voffB); PG8_STAGE(PG8_SA(1, 0), cA + kstep, voffA); PG8_STAGE(PG8_SB(1, 1), cB + hstepB + kstep, voffB);
        PG8_WAIT_V(6); PG8_BAR;
    } else {
        PG8_STAGE(PG8_SB(0, 0), cB, voffB); PG8_STAGE(PG8_SA(0, 0), cA, voffA); PG8_STAGE(PG8_SB(0, 1), cB + hstepB, voffB); PG8_STAGE(PG8_SA(0, 1), cA + hstepA, voffA);
        if (wr == 1) PG8_BAR;
        PG8_WAIT_V(4); PG8_BAR;
        PG8_STAGE(PG8_SB(1, 0), cB + kstep, voffB); PG8_STAGE(PG8_SA(1, 0), cA + kstep, voffA); PG8_STAGE(PG8_SB(1, 1), cB + hstepB + kstep, voffB);
        PG8_WAIT_V(6); PG8_BAR;
    }
    for (;;) {
        const bool has_next = S.next(ui + 1, nxt);
        const char* nA = has_next ? (const char*)g.A + (size_t)nxt.pm * tstepA : cA; const char* nB = has_next ? (const char*)g.Bt + (size_t)nxt.pn * tstepB : cB;
        for (int t = 0; t < nt; t += 2) {
            const bool last = (t == nt - 2);
            const char* a1 = cA + (size_t)(t + 1) * kstep;
            const char* a2 = last ? nA : cA + (size_t)(t + 2) * kstep; const char* b2 = last ? nB : cB + (size_t)(t + 2) * kstep;
            const char* a3 = a2 + kstep; const char* b3 = b2 + kstep;
            if (last && has_next) S.a_ready(nxt);
            if constexpr (SP2) {
            PG8_LDB(B0, 0, 0); PG8_LDB(B1, 0, 1); PG8_SCHED; PG8_LDA(At, 0, 0); PG8_STAGE(PG8_SA(1, 1), a1 + hstepA, voffA);
            PG8_WAIT_V(8); PG8_WAIT_L(0); PG8_BAR; PG8_MMA(0, 0, At, B0); PG8_MMA(0, 1, At, B1); PG8_BAR; PG8_SCHED;
            PG8_LDA(At, 0, 1); PG8_STAGE(PG8_SB(0, 0), b2, voffB); PG8_STAGE(PG8_SB(0, 1), b2 + hstepB, voffB); PG8_STAGE(PG8_SA(0, 0), a2, voffA);
            PG8_WAIT_V(8); PG8_WAIT_L(0); PG8_BAR; PG8_MMA(1, 0, At, B0); PG8_MMA(1, 1, At, B1); PG8_BAR; PG8_SCHED;
            PG8_LDB(B0, 1, 0); PG8_LDB(B1, 1, 1); PG8_SCHED; PG8_LDA(At, 1, 0); PG8_STAGE(PG8_SA(0, 1), a2 + hstepA, voffA);
            PG8_WAIT_V(8); PG8_WAIT_L(0); PG8_BAR; PG8_MMA(0, 0, At, B0); PG8_MMA(0, 1, At, B1); PG8_BAR; PG8_SCHED;
            PG8_LDA(At, 1, 1); PG8_STAGE(PG8_SB(1, 0), b3, voffB); PG8_STAGE(PG8_SB(1, 1), b3 + hstepB, voffB); PG8_STAGE(PG8_SA(1, 0), a3, voffA);
            PG8_WAIT_V(8); PG8_WAIT_L(0); PG8_BAR; PG8_MMA(1, 0, At, B0); PG8_MMA(1, 1, At, B1); PG8_BAR; PG8_SCHED;
            } else {
            PG8_LDB(B0, 0, 0); PG8_SCHED; PG8_LDA(At, 0, 0); PG8_STAGE(PG8_SA(1, 1), a1 + hstepA, voffA);
            PG8_WAIT_L(8); PG8_BAR; PG8_WAIT_L(0); PG8_MMA(0, 0, At, B0); PG8_BAR; PG8_SCHED;
            PG8_LDB(B1, 0, 1); PG8_STAGE(PG8_SB(0, 0), b2, voffB);
            PG8_BAR; PG8_WAIT_L(0); PG8_MMA(0, 1, At, B1); PG8_BAR;
            PG8_LDA(At, 0, 1); PG8_STAGE(PG8_SA(0, 0), a2, voffA);
            PG8_BAR; PG8_WAIT_L(0); PG8_MMA(1, 0, At, B0); PG8_BAR; PG8_SCHED;
            PG8_STAGE(PG8_SB(0, 1), b2 + hstepB, voffB);
            PG8_WAIT_V(6); PG8_BAR; PG8_MMA(1, 1, At, B1); PG8_BAR;
            PG8_LDB(B0, 1, 0); PG8_SCHED; PG8_LDA(At, 1, 0); PG8_STAGE(PG8_SA(0, 1), a2 + hstepA, voffA);
            PG8_WAIT_L(8); PG8_BAR; PG8_WAIT_L(0); PG8_MMA(0, 0, At, B0); PG8_BAR; PG8_SCHED;
            PG8_LDB(B1, 1, 1); PG8_STAGE(PG8_SB(1, 0), b3, voffB);
            PG8_BAR; PG8_WAIT_L(0); PG8_MMA(0, 1, At, B1); PG8_BAR;
            PG8_LDA(At, 1, 1); PG8_STAGE(PG8_SA(1, 0), a3, voffA);
            PG8_BAR; PG8_WAIT_L(0); PG8_MMA(1, 0, At, B0); PG8_BAR; PG8_SCHED;
            PG8_STAGE(PG8_SB(1, 1), b3 + hstepB, voffB);
            PG8_WAIT_V(6); PG8_BAR; PG8_MMA(1, 1, At, B1); PG8_BAR;
            }
        }
        if constexpr (ALIGN_EPI) { if (wr == 0) PG8_BAR; }
        if constexpr (!Epi::AFTER_DRAIN) { E(acc, cur, wr, wc, fr, fq); S.done(cur); }
        if (!has_next) break;
#pragma unroll
        for (int a = 0; a < 2; ++a)
#pragma unroll
            for (int b = 0; b < 2; ++b)
#pragma unroll
                for (int m = 0; m < 4; ++m)
#pragma unroll
                    for (int n = 0; n < 2; ++n) acc[a][b][m][n] = (f32x4){0.f, 0.f, 0.f, 0.f};
        cur = nxt; cA = nA; cB = nB; ++ui;
        if constexpr (ALIGN_EPI) { if (wr == 1) PG8_BAR; }
    }
    PG8_WAIT_V(0);
    if constexpr (!ALIGN_EPI) { if (wr == 0) PG8_BAR; }
    PG8_BAR;
    if constexpr (Epi::AFTER_DRAIN) { E.fused(acc, cur, wr, wc, fr, fq, lds, wid, lane); S.done(cur); }
#undef PG8_SA
#undef PG8_SB
#undef PG8_STAGE
#undef PG8_LDA
#undef PG8_LDB
#undef PG8_MMA
#undef PG8_WAIT_V
#undef PG8_WAIT_L
#undef PG8_BAR
#undef PG8_SCHED
}
}


#define GAS __attribute__((address_space(1)))
#define LAS __attribute__((address_space(3)))
typedef GAS unsigned gu32;
#define RLX_AGENT __ATOMIC_RELAXED, __HIP_MEMORY_SCOPE_AGENT
constexpr int RING_BYTES = 131072;
constexpr int LDSCTL_OFF = RING_BYTES, MISC_OFF = LDSCTL_OFF + 320;
constexpr int LDS_BYTES = 147456;
#ifndef CUT_MASK
#define CUT_MASK 0x00
#endif
constexpr int N_PHASES = 8;

#define XB_TMO      128
#define XB_XCNT(j)  (256  + 64 * (j))
#define XB_XSUB(j)  (1280 + 64 * (j))
#define XB_XGEN(j)  (2304 + 64 * (j))
#define XB_TOP      3328
#define XB_TOPGEN   3392
#define XCD_BAR_WORDS 3456
#define XB_SPIN_CAP (1u << 22)

__device__ __forceinline__ unsigned xb_ld(unsigned* p)              { return __hip_atomic_load(p, __ATOMIC_RELAXED, __HIP_MEMORY_SCOPE_AGENT); }
__device__ __forceinline__ unsigned xb_add(unsigned* p, unsigned v) { return __hip_atomic_fetch_add(p, v, __ATOMIC_RELAXED, __HIP_MEMORY_SCOPE_AGENT); }
__device__ __forceinline__ unsigned xb_xcc_id() { return (unsigned)__builtin_amdgcn_s_getreg((3 << 11) | 20) & 0xFu; }
#define XB_SPIN(cond, bar) do { unsigned _sp = 0; while (cond) { __builtin_amdgcn_s_sleep(1); \
    if ((++_sp & 255u) == 0u) { if (xb_ld(&(bar)[XB_TMO])) break; if (_sp > XB_SPIN_CAP) { atomicAdd(&(bar)[XB_TMO], 1u); break; } } } } while (0)

struct XcdBarrier {
    unsigned* bar; unsigned x;
    volatile LAS unsigned* st;
};

__device__ __forceinline__ XcdBarrier xcd_barrier_post(unsigned* bar, volatile LAS unsigned* st) {
    XcdBarrier b; b.bar = bar; b.x = xb_xcc_id(); b.st = st;
    if (threadIdx.x == 0) (void)xb_add(&bar[XB_XCNT(b.x)], 1u);
    return b;
}
__device__ __forceinline__ void xcd_barrier_complete(unsigned* bar, unsigned x, unsigned& nloc, unsigned& nx) {
    const unsigned G = gridDim.x * gridDim.y * gridDim.z;
    unsigned sum, cnt, mine, sp = 0u;
    for (;;) {
        sum = 0u; cnt = 0u; mine = 0u;
#pragma unroll
        for (unsigned j = 0; j < 16; ++j) { const unsigned c = xb_ld(&bar[XB_XCNT(j)]); sum += c; cnt += (c > 0u) ? 1u : 0u; mine = (j == x) ? c : mine; }
        if (sum == G) break;
        __builtin_amdgcn_s_sleep(1);
        if ((++sp & 255u) == 0u) { if (xb_ld(&bar[XB_TMO])) break; if (sp > XB_SPIN_CAP) { atomicAdd(&bar[XB_TMO], 1u); break; } }
    }
    nloc = mine > 0u ? mine : 1u; nx = cnt > 0u ? cnt : 1u;
}

__device__ __forceinline__ void xcd_barrier(const XcdBarrier& b) {
    asm volatile("s_waitcnt vmcnt(0)" ::: "memory");
    __syncthreads();
    if (threadIdx.x == 0) {
        unsigned* bar = b.bar;
        __builtin_amdgcn_s_waitcnt(0);
        unsigned nloc = b.st[0], nx = b.st[1];
        if (nloc == 0u) { xcd_barrier_complete(bar, b.x, nloc, nx); b.st[0] = nloc; b.st[1] = nx; }
        const unsigned old = xb_add(&bar[XB_XSUB(b.x)], 1u);
        const unsigned gen = old / nloc;
        if (old + 1u == (gen + 1u) * nloc) {
            __builtin_amdgcn_fence(__ATOMIC_RELEASE, "agent");
            asm volatile("s_waitcnt vmcnt(0)" ::: "memory");
            const unsigned og = xb_add(&bar[XB_TOP], 1u);
            const unsigned tg = og / nx;
            if (og + 1u == (tg + 1u) * nx) xb_add(&bar[XB_TOPGEN], 1u);
            else XB_SPIN(xb_ld(&bar[XB_TOPGEN]) == tg, bar);
            __builtin_amdgcn_fence(__ATOMIC_ACQUIRE, "agent");
            xb_add(&bar[XB_XGEN(b.x)], 1u);
            asm volatile("s_waitcnt vmcnt(0)" ::: "memory");
        } else {
            XB_SPIN(xb_ld(&bar[XB_XGEN(b.x)]) == gen, bar);
            __builtin_amdgcn_fence(__ATOMIC_ACQUIRE, "agent");
            asm volatile("s_waitcnt vmcnt(0)" ::: "memory");
        }
    }
    __syncthreads();
}


enum { TM_IN = 0, TM_UQ = 1, TM_UKV = 2, TM_OUT = 3 };
__device__ __forceinline__ int dst_row(int mode, int n) {
    if (mode == TM_IN) {
        if (n < 4096) return n;
        if (n < 4112) return NPROJ + (n - 4096);
        if (n < 6160) return PC_GGATE + (n - 4112);
        if (n < 7696) return PC_MCQ + (n - 6160);
        if (n < 8208) return PC_MCKV + (n - 7696);
        if (n < 8272) { const int p = n - 8208; return NPROJ + 16 + 2 * (p & 31) + (p >> 5); }
        return PC_MGATE + (n - 8272);
    } else if (mode == TM_UQ) {
        const int h = n / 192, d = n % 192;
        if (d < 128) return h * 128 + d;
        const int p = d - 128; return 2048 + h * 64 + 2 * (p & 31) + (p >> 5);
    } else if (mode == TM_UKV) {
        const int h = n / 256, d = n % 256;
        return d < 128 ? h * 128 + d : 2048 + h * 128 + (d - 128);
    } else return n;
}
struct TrMat { const float* W; bf16_t* WT; const float* rowscale; int K, N, mode, nblk; };
__device__ __forceinline__ void tr_load(const TrMat& t, int item, int lane, f32x4 (&v)[16]) {
    const int kb = item / t.nblk, nb = item - kb * t.nblk, k0 = 64 * kb, n0 = 64 * nb, c = lane & 15, rp = lane >> 4;
    const bool ok = n0 + 4 * c < t.N;
    const float* p = t.W + (size_t)(k0 + 2 * rp) * t.N + n0 + 4 * c;
#pragma unroll
    for (int i = 0; i < 8; ++i)
#pragma unroll
        for (int j = 0; j < 2; ++j) v[2 * i + j] = ok ? __builtin_nontemporal_load((const f32x4*)(p + (size_t)(8 * i + j) * t.N)) : (f32x4){0.f, 0.f, 0.f, 0.f};
}
__device__ __forceinline__ unsigned cvtpk_rne(float lo, float hi) { unsigned r; asm volatile("v_cvt_pk_bf16_f32 %0, %1, %2" : "=v"(r) : "v"(lo), "v"(hi)); return r; }
__device__ __forceinline__ void tr_store(const TrMat& t, int item, int lane, const f32x4 (&v)[16], float* scrf) {
    unsigned* scr = (unsigned*)scrf;
    const int kb = item / t.nblk, nb = item - kb * t.nblk, k0 = 64 * kb, n0 = 64 * nb, c = lane & 15, rp = lane >> 4;
    const float cs = (t.mode == TM_IN && n0 < 1024) ? 0.125f : 1.f;
#pragma unroll
    for (int i = 0; i < 8; ++i) { const int kk = 2 * rp + 8 * i; const float s0 = (t.rowscale ? t.rowscale[k0 + kk] : 1.f) * cs, s1 = (t.rowscale ? t.rowscale[k0 + kk + 1] : 1.f) * cs;
        unsigned* d = scr + (rp + 4 * i) * 65 + 4 * c;
        d[0] = cvtpk_rne(v[2 * i][0] * s0, v[2 * i + 1][0] * s1); d[1] = cvtpk_rne(v[2 * i][1] * s0, v[2 * i + 1][1] * s1);
        d[2] = cvtpk_rne(v[2 * i][2] * s0, v[2 * i + 1][2] * s1); d[3] = cvtpk_rne(v[2 * i][3] * s0, v[2 * i + 1][3] * s1); }
    __builtin_amdgcn_s_waitcnt(0xC07F); asm volatile("" ::: "memory");
    const int q = lane & 7, nr = lane >> 3;
#pragma unroll
    for (int j = 0; j < 8; ++j) { const int n = nr + 8 * j; const unsigned* s = scr + (4 * q) * 65 + n;
        if (n0 + n < t.N) { u32x4 o; o.x = s[0]; o.y = s[65]; o.z = s[130]; o.w = s[195];
            *(u32x4*)(t.WT + (size_t)dst_row(t.mode, n0 + n) * t.K + k0 + 8 * q) = o; } }
    __builtin_amdgcn_s_waitcnt(0xC07F); asm volatile("" ::: "memory");
}
__device__ __forceinline__ float mod_at(const float* __restrict__ MODP, const float* __restrict__ b_ada, int j) {
    float v = b_ada[j];
#pragma unroll
    for (int s = 0; s < 16; ++s) v += MODP[(size_t)s * 12288 + j];
    return v;
}
__device__ __forceinline__ f32x2 cos_sin_f32arg(float ang) {
    const double a = (double)ang;
    const double n = __builtin_rint(a * 0.63661977236758134308);
    double r = __builtin_fma(-n, 1.57079632679489655800e+00, a); r = __builtin_fma(-n, 6.12323399573676603587e-17, r);
    const double r2 = r * r;
    const double sn = r + r * r2 * (-1.0 / 6 + r2 * (1.0 / 120 + r2 * (-1.0 / 5040 + r2 * (1.0 / 362880 + r2 * (-1.0 / 39916800)))));
    const double cs = 1.0 + r2 * (-0.5 + r2 * (1.0 / 24 + r2 * (-1.0 / 720 + r2 * (1.0 / 40320 + r2 * (-1.0 / 3628800 + r2 * (1.0 / 479001600))))));
    const int q = ((int)(long long)n) & 3;
    double co, si;
    if (q == 0) { co = cs; si = sn; } else if (q == 1) { co = -sn; si = cs; } else if (q == 2) { co = -cs; si = -sn; } else { co = sn; si = -cs; }
    return (f32x2){(float)co, (float)si};
}
struct P0Args { const float *w_in, *w_uq, *w_ukv, *w_out, *g_qn, *g_kvn, *c, *w_ada; const int* pos; bf16_t *WTALL, *WTUQ, *WTUKV, *WTOUT; float* MODP; f32x2* ROPE; };
__device__ __forceinline__ void p0_prologue(const P0Args& a, float* ldsf, int vcu, int G) {
    const int tid = threadIdx.x, wave = tid >> 6, lane = tid & 63;
    float* scr = ldsf + wave * (64 * 33); float* sc = ldsf + 8 * 64 * 33;
    for (int i = tid; i < DM; i += NT) sc[i] = silu_f(a.c[i]);
    __syncthreads();
    const int gw = vcu * NWAVES + wave, NGW = G * NWAVES;
    if (G == 256) {
        const int s = vcu >> 4, cset = vcu & 15, kb = s * 256 + wave * 32;
        const float* wp = a.w_ada + (size_t)kb * 12288 + cset * 768 + 4 * lane;
        f32x4 acc0 = {0.f, 0.f, 0.f, 0.f}, acc1 = acc0, acc2 = acc0;
#pragma unroll 8
        for (int k = 0; k < 32; ++k) { const float av = sc[kb + k]; const f32x4* rp = (const f32x4*)(wp + (size_t)k * 12288);
            const f32x4 w0 = __builtin_nontemporal_load(rp), w1 = __builtin_nontemporal_load(rp + 64), w2 = __builtin_nontemporal_load(rp + 128);
            acc0 += av * w0; acc1 += av * w1; acc2 += av * w2; }
        float* red = ldsf + wave * 768 + 4 * lane;
        *(f32x4*)red = acc0; *(f32x4*)(red + 256) = acc1; *(f32x4*)(red + 512) = acc2;
        __syncthreads();
        for (int e = tid; e < 768; e += NT) { float t = 0.f;
#pragma unroll
            for (int w = 0; w < 8; ++w) t += ldsf[w * 768 + e];
            a.MODP[(size_t)s * 12288 + cset * 768 + e] = t; }
        __syncthreads();
    } else
    for (int task = gw; task < 96 * 16; task += NGW) {
        const int g = task % 96, s = task / 96, k0 = s * 256;
        const float* wp = a.w_ada + (size_t)k0 * 12288 + g * 128 + 2 * lane;
        f32x2 acc = {0.f, 0.f};
#pragma unroll 16
        for (int k = 0; k < 256; ++k) { const f32x2 w = __builtin_nontemporal_load((const f32x2*)(wp + (size_t)k * 12288)); const float av = sc[k0 + k]; acc.x += av * w.x; acc.y += av * w.y; }
        *(f32x2*)(a.MODP + (size_t)s * 12288 + g * 128 + 2 * lane) = acc;
    }
    constexpr int I_IN = (DM / 64) * ((IN_WIDTH + 63) / 64), I_UQ = (QRANK / 64) * (NQ / 64), I_UKV = (KVRANK / 64) * (NKV / 64), I_OUT = (DM / 64) * (DM / 64), I_ALL = I_IN + I_UQ + I_UKV + I_OUT;
    const TrMat mIN{a.w_in, a.WTALL, nullptr, DM, IN_WIDTH, TM_IN, (IN_WIDTH + 63) / 64}, mUQ{a.w_uq, a.WTUQ, a.g_qn, QRANK, NQ, TM_UQ, NQ / 64},
                mUKV{a.w_ukv, a.WTUKV, a.g_kvn, KVRANK, NKV, TM_UKV, NKV / 64}, mOUT{a.w_out, a.WTOUT, nullptr, DM, DM, TM_OUT, DM / 64};
#define TR_PICK(it_, M_, r_) do { r_ = (it_); if (r_ < I_IN) M_ = mIN; else { r_ -= I_IN; if (r_ < I_UQ) M_ = mUQ; else { r_ -= I_UQ; if (r_ < I_UKV) M_ = mUKV; else { r_ -= I_UKV; M_ = mOUT; } } } } while (0)
    { int it = (G == 256) ? gw : (gw + NGW - (96 * 16) % NGW) % NGW; f32x4 v[16], vn[16]; TrMat M = mIN, Mn = mIN; int r = 0, rn = 0;
      if (it < I_ALL) { TR_PICK(it, M, r); tr_load(M, r, lane, v); }
      while (it < I_ALL) { const int nxt = it + NGW;
          if (nxt < I_ALL) { TR_PICK(nxt, Mn, rn); tr_load(Mn, rn, lane, vn); }
          tr_store(M, r, lane, v, scr);
#pragma unroll
          for (int i = 0; i < 16; ++i) v[i] = vn[i];
          M = Mn; r = rn; it = nxt; } }
#undef TR_PICK
    for (int idx = vcu * NT + tid; idx < S * 32; idx += G * NT) {
        const int s = idx >> 5, i = idx & 31;
        const float inv_freq = powf(10000.0f, -(float)i / 32.0f);
        a.ROPE[idx] = cos_sin_f32arg((float)a.pos[s] * inv_freq);
    }
}
__device__ __forceinline__ void p1_hnorm(const float* __restrict__ x, const float* __restrict__ g_pre, const float* __restrict__ MODP, const float* __restrict__ b_ada, bf16_t* __restrict__ H, float* ldsf, int vcu, int G) {
    float* tA = ldsf; float* tB = ldsf + DM;
    { float sh[8], sc[8];
#pragma unroll
      for (int j = 0; j < 8; ++j) { sh[j] = b_ada[threadIdx.x + NT * j]; sc[j] = b_ada[DM + threadIdx.x + NT * j]; }
#pragma unroll 4
      for (int s = 0; s < 16; ++s) { const float* mp = MODP + (size_t)s * 12288 + threadIdx.x;
#pragma unroll
          for (int j = 0; j < 8; ++j) { sh[j] += mp[NT * j]; sc[j] += mp[DM + NT * j]; } }
#pragma unroll
      for (int j = 0; j < 8; ++j) { const int c = threadIdx.x + NT * j; tA[c] = g_pre[c] * (1.f + sc[j]); tB[c] = sh[j]; } }
    __syncthreads();
    const int wave = threadIdx.x >> 6, lane = threadIdx.x & 63;
    for (int m = vcu * NWAVES + wave; m < S; m += G * NWAVES) {
        const f32x4* xr = (const f32x4*)(x + (size_t)m * DM) + lane;
        f32x4 v[16]; float ss = 0.f;
#pragma unroll
        for (int j = 0; j < 16; ++j) { v[j] = __builtin_nontemporal_load(xr + 64 * j); ss += (v[j].x * v[j].x + v[j].y * v[j].y) + (v[j].z * v[j].z + v[j].w * v[j].w); }
        const float rstd = 1.0f / sqrtf(wave_sum(ss) * (1.f / DM) + EPS);
        u32x2* o = (u32x2*)(H + (size_t)m * DM) + lane;
#pragma unroll
        for (int j = 0; j < 16; ++j) { const int c = 256 * j + 4 * lane;
            const f32x4 av = *(const f32x4*)(tA + c), bv = *(const f32x4*)(tB + c);
            u32x2 w; w.x = pk2(v[j].x * rstd * av.x + bv.x, v[j].y * rstd * av.y + bv.y); w.y = pk2(v[j].z * rstd * av.z + bv.z, v[j].w * rstd * av.w + bv.w);
            o[64 * j] = w; }
    }
    __syncthreads();
}
constexpr int TB_PITCH = 544;
constexpr size_t THINP_STRIDE = (size_t)S * NTHIN;
__device__ __forceinline__ void thin_gemm(const bf16_t* __restrict__ H, const bf16_t* __restrict__ WTHIN, float* __restrict__ THINP, float* ldsf, int vcu, int G) {
    const int tid = threadIdx.x, wave = tid >> 6, lane = tid & 63, fr = lane & 15, fq = lane >> 4;
    char* lb = (char*)ldsf;
    const int srow = tid >> 5, sc16 = tid & 31;
    for (int it = vcu; it < 256; it += G) {
        const int rbk = it >> 2, kq = it & 3;
        const bf16_t* ap = H + (size_t)(rbk * 128 + wave * 16 + fr) * DM + kq * 1024 + 8 * fq;
        const bf16_t* bg = WTHIN + (size_t)srow * DM + kq * 1024 + sc16 * 8;
        f32x4 acc[5];
#pragma unroll
        for (int j = 0; j < 5; ++j) acc[j] = (f32x4){0.f, 0.f, 0.f, 0.f};
        bf16x8 st[5], av[8];
#pragma unroll
        for (int i = 0; i < 5; ++i) st[i] = *(const bf16x8*)(bg + (size_t)(16 * i) * DM);
#pragma unroll
        for (int ks = 0; ks < 8; ++ks) av[ks] = *(const bf16x8*)(ap + ks * 32);
#pragma unroll
        for (int i = 0; i < 5; ++i) *(bf16x8*)(lb + (srow + 16 * i) * TB_PITCH + sc16 * 16) = st[i];
        __syncthreads();
#pragma unroll
        for (int c = 0; c < 4; ++c) {
            const char* cur = lb + (c & 1) * (80 * TB_PITCH) + fr * TB_PITCH + fq * 16;
            bf16x8 an[8];
            if (c + 1 < 4) {
#pragma unroll
                for (int i = 0; i < 5; ++i) st[i] = *(const bf16x8*)(bg + (size_t)(16 * i) * DM + (c + 1) * 256);
#pragma unroll
                for (int ks = 0; ks < 8; ++ks) an[ks] = *(const bf16x8*)(ap + (c + 1) * 256 + ks * 32);
            }
            __builtin_amdgcn_sched_barrier(0);
#pragma unroll
            for (int ks = 0; ks < 8; ++ks)
#pragma unroll
                for (int j = 0; j < 5; ++j) { const bf16x8 bv = *(const bf16x8*)(cur + (16 * j) * TB_PITCH + ks * 64); acc[j] = __builtin_amdgcn_mfma_f32_16x16x32_bf16(bv, av[ks], acc[j], 0, 0, 0); }
            __builtin_amdgcn_sched_barrier(0);
            if (c + 1 < 4) {
#pragma unroll
                for (int i = 0; i < 5; ++i) *(bf16x8*)(lb + ((c + 1) & 1) * (80 * TB_PITCH) + (srow + 16 * i) * TB_PITCH + sc16 * 16) = st[i];
#pragma unroll
                for (int ks = 0; ks < 8; ++ks) av[ks] = an[ks];
            }
            __syncthreads();
        }
        float* op = THINP + (size_t)kq * THINP_STRIDE + (size_t)(rbk * 128 + wave * 16 + fr) * NTHIN + 4 * fq;
#pragma unroll
        for (int j = 0; j < 5; ++j) *(f32x4*)(op + 16 * j) = acc[j];
    }
}
__device__ __forceinline__ void p3_krope(const float* __restrict__ THIN, const f32x2* __restrict__ ROPE, bf16_t* __restrict__ KR, int vcu, int G) {
    for (int idx = vcu * NT + threadIdx.x; idx < S * 32; idx += G * NT) { const int m = idx >> 5, i = idx & 31;
        const float* tp = THIN + (size_t)m * NTHIN + 16 + 2 * i;
        const f32x2 xx = (*(const f32x2*)tp + *(const f32x2*)(tp + THINP_STRIDE)) + (*(const f32x2*)(tp + 2 * THINP_STRIDE) + *(const f32x2*)(tp + 3 * THINP_STRIDE)); const f32x2 cs = ROPE[idx];
        *(unsigned*)(KR + (size_t)m * 64 + 2 * i) = pk2(xx.x * cs.x - xx.y * cs.y, xx.y * cs.x + xx.x * cs.y); }
}
__device__ __forceinline__ void p7_final(const float* __restrict__ x, const bf16_t* __restrict__ MIXB, const float* __restrict__ SSQMIX, const float* __restrict__ g_post, const float* __restrict__ MODP, const float* __restrict__ b_ada, float* __restrict__ out, float* ldsf, int vcu, int G) {
    float* tG = ldsf;
    { float gt[8];
#pragma unroll
      for (int j = 0; j < 8; ++j) gt[j] = b_ada[2 * DM + threadIdx.x + NT * j];
#pragma unroll 8
      for (int s = 0; s < 16; ++s) { const float* mp = MODP + (size_t)s * 12288 + 2 * DM + threadIdx.x;
#pragma unroll
          for (int j = 0; j < 8; ++j) gt[j] += mp[NT * j]; }
#pragma unroll
      for (int j = 0; j < 8; ++j) { const int c = threadIdx.x + NT * j; tG[c] = gt[j] * g_post[c]; } }
    __syncthreads();
    const int wave = threadIdx.x >> 6, lane = threadIdx.x & 63;
    for (int m = vcu * NWAVES + wave; m < S; m += G * NWAVES) {
        const float rstd = 1.0f / sqrtf(wave_sum(SSQMIX[(size_t)m * 64 + lane]) * (1.f / DM) + EPS);
        const u32x2* mr = (const u32x2*)(MIXB + (size_t)m * DM) + lane; const f32x4* xr = (const f32x4*)(x + (size_t)m * DM) + lane;
        f32x4* o = (f32x4*)(out + (size_t)m * DM) + lane;
#pragma unroll
        for (int jj = 0; jj < 16; jj += 8) { f32x4 xv[8]; u32x2 mv[8];
#pragma unroll
            for (int j = 0; j < 8; ++j) { xv[j] = __builtin_nontemporal_load(xr + 64 * (jj + j)); mv[j] = __builtin_nontemporal_load(mr + 64 * (jj + j)); }
#pragma unroll
            for (int j = 0; j < 8; ++j) { const f32x4 g = *(const f32x4*)(tG + 256 * (jj + j) + 4 * lane);
                const f32x4 mf = {__uint_as_float(mv[j].x << 16), __uint_as_float(mv[j].x & 0xffff0000u), __uint_as_float(mv[j].y << 16), __uint_as_float(mv[j].y & 0xffff0000u)};
                __builtin_nontemporal_store(xv[j] + g * (mf * rstd), o + 64 * (jj + j)); } }
    }
}


namespace att {
typedef short s16x4 __attribute__((ext_vector_type(4)));
typedef float f32x16 __attribute__((ext_vector_type(16)));
constexpr int NW = 8, QBLK = 32, KVBLK = 64, QB = NW * QBLK;
constexpr int SHM_V = KVBLK * 128 * 2, SHM_K = KVBLK * 384;
constexpr int LDS_K = 2 * SHM_V, LDS_WS = 2 * SHM_V + 2 * SHM_K, LDS_QR = LDS_WS + NW * 64 * 4, LDS_BYTES = LDS_QR + NW * 4096;
constexpr float THR = 6.f;
#define ATT_KOFF(row, c) ((row) * 384 + ((((c) & ~7) | (((c) & 7) ^ (((row) >> 1) & 7))) << 4))
#define SBAR() __builtin_amdgcn_sched_barrier(0)
__device__ __forceinline__ int v_st(int k, int c) { const int kk = (k & ~0xC) | ((k & 4) << 1) | ((k & 8) >> 1); return ((kk >> 3) * 4 + (c >> 5)) * 512 + ((kk & 7) * 32 + (c & 31)) * 2; }
__device__ __forceinline__ int v_rd_base(int lane) { return ((lane & 3) << 3) | (((lane >> 2) & 3) << 6) | (((lane >> 4) & 1) << 5) | (((lane >> 5) & 1) << 8); }
constexpr int v_rd_off(int d0, int ks, int half) { return d0 * 512 + ks * 4096 + half * 2048; }
__device__ __forceinline__ int crow(int r, int hi) { return (r & 3) + 8 * (r >> 2) + 4 * hi; }
typedef float f32x2_t __attribute__((ext_vector_type(2))); typedef __bf16 bf16x2_t __attribute__((ext_vector_type(2)));
__device__ __forceinline__ unsigned cvtpk(float lo, float hi) { f32x2_t v = {lo, hi}; bf16x2_t b = __builtin_convertvector(v, bf16x2_t); return __builtin_bit_cast(unsigned, b); }

__device__ __forceinline__ void partialSM(f32x16& p0, f32x16& p1, float& m_reg, float& alpha, bool act) {
    float pmax = p0[0];
#pragma unroll
    for (int r = 1; r < 16; ++r) pmax = fmaxf(pmax, p0[r]);
#pragma unroll
    for (int r = 0; r < 16; ++r) pmax = fmaxf(pmax, p1[r]);
    { auto rr = __builtin_amdgcn_permlane32_swap(__float_as_uint(pmax), __float_as_uint(pmax), false, false);
      pmax = fmaxf(__uint_as_float(rr[0]), __uint_as_float(rr[1])); }
    if (!act) pmax = -__builtin_inff();
    float mn;
    if (__builtin_expect(__all((pmax - m_reg) <= THR), 1)) { mn = m_reg; alpha = 1.f; }
    else { mn = fmaxf(m_reg, pmax); alpha = __builtin_amdgcn_exp2f(m_reg - mn); m_reg = mn; }
    if (!act) mn = __builtin_inff();
#pragma unroll
    for (int r = 0; r < 16; ++r) p0[r] = p0[r] - mn;
#pragma unroll
    for (int r = 0; r < 16; ++r) p1[r] = p1[r] - mn;
#pragma unroll
    for (int r = 0; r < 16; ++r) p0[r] = __builtin_amdgcn_exp2f(p0[r]);
}
__device__ __forceinline__ void finishSM(f32x16& p0, f32x16& p1, float alpha, float& l_reg, bf16x8& pa0, bf16x8& pa1, bf16x8& pa2, bf16x8& pa3) {
#pragma unroll
    for (int r = 0; r < 16; ++r) p1[r] = __builtin_amdgcn_exp2f(p1[r]);
    float ps = 0;
#pragma unroll
    for (int r = 0; r < 16; ++r) ps += p0[r];
#pragma unroll
    for (int r = 0; r < 16; ++r) ps += p1[r];
    { auto rr = __builtin_amdgcn_permlane32_swap(__float_as_uint(ps), __float_as_uint(ps), false, false);
      ps = __uint_as_float(rr[0]) + __uint_as_float(rr[1]); }
    l_reg = l_reg * alpha + ps;
#define PK4(P, B_, OUT) do { unsigned a0 = cvtpk(P[B_+0], P[B_+1]), a1 = cvtpk(P[B_+2], P[B_+3]);                          \
        unsigned b0 = cvtpk(P[B_+4], P[B_+5]), b1 = cvtpk(P[B_+6], P[B_+7]);                                             \
        auto r0 = __builtin_amdgcn_permlane32_swap(a0, b0, false, false); auto r1 = __builtin_amdgcn_permlane32_swap(a1, b1, false, false); \
        u32x4 w = {r0[0], r1[0], r0[1], r1[1]}; OUT = *reinterpret_cast<bf16x8*>(&w); } while (0)
    PK4(p0, 0, pa0); PK4(p0, 8, pa1); PK4(p1, 0, pa2); PK4(p1, 8, pa3);
#undef PK4
}
template <int KB>
__device__ __forceinline__ void qkt(f32x16& p0, f32x16& p1, const char* K_lds, int r32, int hi, const bf16x8* qr, const char* qlds) {
    p0 = f32x16{}; p1 = f32x16{};
    const char* kb[4];
#pragma unroll
    for (int dd = 0; dd < 4; ++dd) kb[dd] = K_lds + KB * SHM_K + ATT_KOFF(r32, 2 * dd + hi);
#pragma unroll
    for (int d0 = 0; d0 < 12; ++d0) { const char* a = kb[d0 & 3] + (d0 >> 2) * 128;
        bf16x8 b0 = *reinterpret_cast<const bf16x8*>(a);
        bf16x8 b1 = *reinterpret_cast<const bf16x8*>(a + 32 * 384);
        const bf16x8 qf = d0 < 8 ? qr[d0] : *reinterpret_cast<const bf16x8*>(qlds + (d0 - 8) * 1024);
        p0 = __builtin_amdgcn_mfma_f32_32x32x16_bf16(b0, qf, p0, 0, 0, 0);
        p1 = __builtin_amdgcn_mfma_f32_32x32x16_bf16(b1, qf, p1, 0, 0, 0); }
}
template <int KB>
__device__ __forceinline__ void qkt_fsm(f32x16& p0, f32x16& p1, const char* K_lds, int r32, int hi, const bf16x8* qr, const char* qlds,
                                        f32x16& y0, f32x16& y1, float alpha, float& l_reg, bf16x8& pa0, bf16x8& pa1, bf16x8& pa2, bf16x8& pa3) {
    p0 = f32x16{}; p1 = f32x16{};
    const char* kb[4];
#pragma unroll
    for (int dd = 0; dd < 4; ++dd) kb[dd] = K_lds + KB * SHM_K + ATT_KOFF(r32, 2 * dd + hi);
    bf16x8 b0 = *reinterpret_cast<const bf16x8*>(kb[0]), b1 = *reinterpret_cast<const bf16x8*>(kb[0] + 32 * 384);
    float ps = 0.f; unsigned ca0 = 0, ca1 = 0, cb0 = 0, cb1 = 0; u32x4 w0 = {}, w1 = {}, w2 = {}, w3 = {};
#define FS_SUM4(Y, B_) ps += (Y[B_] + Y[B_ + 1]) + (Y[B_ + 2] + Y[B_ + 3])
#define FS_EXP2(B_) do { y1[B_] = __builtin_amdgcn_exp2f(y1[B_]); y1[B_ + 1] = __builtin_amdgcn_exp2f(y1[B_ + 1]); } while (0)
#define FS_PKH0(Y, B_, W) do { ca0 = cvtpk(Y[B_ + 0], Y[B_ + 1]); cb0 = cvtpk(Y[B_ + 4], Y[B_ + 5]); auto r_ = __builtin_amdgcn_permlane32_swap(ca0, cb0, false, false); W[0] = r_[0]; W[2] = r_[1]; } while (0)
#define FS_PKH1(Y, B_, W) do { ca1 = cvtpk(Y[B_ + 2], Y[B_ + 3]); cb1 = cvtpk(Y[B_ + 6], Y[B_ + 7]); auto r_ = __builtin_amdgcn_permlane32_swap(ca1, cb1, false, false); W[1] = r_[0]; W[3] = r_[1]; } while (0)
#pragma unroll
    for (int d0 = 0; d0 < 12; ++d0) {
        bf16x8 n0 = b0, n1 = b1;
        if (d0 < 11) { const char* an = kb[(d0 + 1) & 3] + ((d0 + 1) >> 2) * 128; n0 = *reinterpret_cast<const bf16x8*>(an); n1 = *reinterpret_cast<const bf16x8*>(an + 32 * 384); }
        const bf16x8 qf = d0 < 8 ? qr[d0] : *reinterpret_cast<const bf16x8*>(qlds + (d0 - 8) * 1024);
        p0 = __builtin_amdgcn_mfma_f32_32x32x16_bf16(b0, qf, p0, 0, 0, 0);
        p1 = __builtin_amdgcn_mfma_f32_32x32x16_bf16(b1, qf, p1, 0, 0, 0);
        if (d0 == 0) { FS_SUM4(y0, 0); FS_PKH0(y0, 0, w0); FS_EXP2(0); }
        if (d0 == 1) { FS_SUM4(y0, 4); FS_PKH1(y0, 0, w0); FS_EXP2(2); }
        if (d0 == 2) { FS_SUM4(y0, 8); FS_PKH0(y0, 8, w1); FS_EXP2(4); }
        if (d0 == 3) { FS_SUM4(y0, 12); FS_PKH1(y0, 8, w1); FS_EXP2(6); }
        if (d0 == 4) { FS_EXP2(8); FS_SUM4(y1, 0); }
        if (d0 == 5) { FS_EXP2(10); FS_SUM4(y1, 4); }
        if (d0 == 6) { FS_EXP2(12); FS_PKH0(y1, 0, w2); }
        if (d0 == 7) { FS_EXP2(14); FS_PKH1(y1, 0, w2); }
        if (d0 == 8) { FS_SUM4(y1, 8); FS_PKH0(y1, 8, w3); }
        if (d0 == 9) { FS_SUM4(y1, 12); FS_PKH1(y1, 8, w3); }
        if (d0 == 10) { auto rr = __builtin_amdgcn_permlane32_swap(__float_as_uint(ps), __float_as_uint(ps), false, false); ps = __uint_as_float(rr[0]) + __uint_as_float(rr[1]); l_reg = l_reg * alpha + ps; }
        b0 = n0; b1 = n1;
        SBAR();
    }
    pa0 = __builtin_bit_cast(bf16x8, w0); pa1 = __builtin_bit_cast(bf16x8, w1); pa2 = __builtin_bit_cast(bf16x8, w2); pa3 = __builtin_bit_cast(bf16x8, w3);
#undef FS_SUM4
#undef FS_EXP2
#undef FS_PKH0
#undef FS_PKH1
}
template <int VB>
__device__ __forceinline__ void pv_tile(f32x16* o, int vb0, bf16x8 pa0, bf16x8 pa1, bf16x8 pa2, bf16x8 pa3) {
#define TRRD(dst, off) asm volatile("ds_read_b64_tr_b16 %0, %1 offset:%2" : "=&v"(dst) : "v"(vb0), "i"(off) : "memory")
#define PV_D0(d0) do { s16x4 l0, l1, l2, l3, h0, h1, h2, h3; constexpr int b_ = VB * SHM_V + v_rd_off(d0, 0, 0); \
        TRRD(l0, b_); TRRD(h0, b_ + 2048); TRRD(l1, b_ + 4096); TRRD(h1, b_ + 6144); TRRD(l2, b_ + 8192); TRRD(h2, b_ + 10240); TRRD(l3, b_ + 12288); TRRD(h3, b_ + 14336); \
        asm volatile("s_waitcnt lgkmcnt(0)" ::: "memory"); SBAR(); \
        o[d0] = __builtin_amdgcn_mfma_f32_32x32x16_bf16(pa0, (bf16x8){l0[0], l0[1], l0[2], l0[3], h0[0], h0[1], h0[2], h0[3]}, o[d0], 0, 0, 0);   \
        o[d0] = __builtin_amdgcn_mfma_f32_32x32x16_bf16(pa1, (bf16x8){l1[0], l1[1], l1[2], l1[3], h1[0], h1[1], h1[2], h1[3]}, o[d0], 0, 0, 0);   \
        o[d0] = __builtin_amdgcn_mfma_f32_32x32x16_bf16(pa2, (bf16x8){l2[0], l2[1], l2[2], l2[3], h2[0], h2[1], h2[2], h2[3]}, o[d0], 0, 0, 0);   \
        o[d0] = __builtin_amdgcn_mfma_f32_32x32x16_bf16(pa3, (bf16x8){l3[0], l3[1], l3[2], l3[3], h3[0], h3[1], h3[2], h3[3]}, o[d0], 0, 0, 0); } while (0)
    PV_D0(0); PV_D0(1); PV_D0(2); PV_D0(3);
#undef PV_D0
#undef TRRD
}
struct Tensors { const bf16_t* Q; const bf16_t* KV; const bf16_t* KR; const bf16_t* PROJ; bf16_t* MIXIN; };
struct Seam { bf16x8 qr[12]; bf16x8 st_v0, st_v1, st_k0, st_k1, st_kr; unsigned g_k, g_kr; int l_k0, l_kr, l_v0; };
#define ATT_VMW() asm volatile("s_waitcnt vmcnt(0)" ::: "memory")
#define ATT_VMWN(n) asm volatile("s_waitcnt vmcnt(%0)" :: "i"(n) : "memory")
#define ATT_OPQ(x) asm volatile("" : "+v"(x))
#define ATT_STG_INIT() do { int t_ = tid; ATT_OPQ(t_); const int sr_ = t_ >> 4, sc_ = (t_ & 15) * 8;                                   \
        S.g_k = (unsigned)(sr_ * NKV + sc_) * 2u; S.g_kr = (unsigned)((t_ >> 3) * 64 + (t_ & 7) * 8) * 2u;                            \
        S.l_k0 = ATT_KOFF(t_ >> 4, t_ & 15); S.l_kr = ATT_KOFF(t_ >> 3, 16 + (t_ & 7)); S.l_v0 = v_st(sr_, sc_);                        \
        ATT_OPQ(S.g_k); ATT_OPQ(S.g_kr); ATT_OPQ(S.l_k0); ATT_OPQ(S.l_kr); ATT_OPQ(S.l_v0); } while (0)
#define ATT_SLOAD(h_, k0) do { const char* kvb_ = (const char*)(T.KV + (size_t)(k0) * NKV + (h_) * 128); const char* krb_ = (const char*)(T.KR + (size_t)(k0) * 64);   \
        S.st_v0 = *(const bf16x8*)(kvb_ + 4096 + S.g_k); S.st_v1 = *(const bf16x8*)(kvb_ + (4096 + 32 * NKV * 2) + S.g_k);             \
        S.st_k0 = *(const bf16x8*)(kvb_ + S.g_k); S.st_k1 = *(const bf16x8*)(kvb_ + 32 * NKV * 2 + S.g_k);                              \
        S.st_kr = *(const bf16x8*)(krb_ + S.g_kr); } while (0)
#define ATT_SWRITE_K(bf) do { *(bf16x8*)(K_lds + (bf) * SHM_K + S.l_k0) = S.st_k0; *(bf16x8*)(K_lds + (bf) * SHM_K + S.l_k0 + 32 * 384) = S.st_k1; *(bf16x8*)(K_lds + (bf) * SHM_K + S.l_kr) = S.st_kr; } while (0)
#define ATT_SWRITE_V(bf) do { *(bf16x8*)(V_lds + (bf) * SHM_V + S.l_v0) = S.st_v0; *(bf16x8*)(V_lds + (bf) * SHM_V + S.l_v0 + 8192) = S.st_v1; } while (0)
#define ATT_QLOAD_N(h_, row0_) do { const bf16_t* qp_ = T.Q + (size_t)((row0_) + wid * QBLK + r32) * NQ;                              \
        _Pragma("unroll") for (int d0 = 0; d0 < 8; ++d0) S.qr[d0] = *(const bf16x8*)(qp_ + (h_) * 128 + d0 * 16 + hi * 8); } while (0)
#define ATT_QLOAD_R(h_, row0_) do { const bf16_t* qp_ = T.Q + (size_t)((row0_) + wid * QBLK + r32) * NQ;                              \
        _Pragma("unroll") for (int d0 = 0; d0 < 4; ++d0) S.qr[8 + d0] = *(const bf16x8*)(qp_ + 2048 + (h_) * 64 + d0 * 16 + hi * 8); } while (0)
#define ATT_QLOAD(h_, row0_) do { ATT_QLOAD_N(h_, row0_); ATT_QLOAD_R(h_, row0_); } while (0)

__device__ __forceinline__ void prime(const Tensors& T, int h, int qb, char* lds, Seam& S) {
    int tid = threadIdx.x; asm volatile("" : "+v"(tid));
    const int wid = __builtin_amdgcn_readfirstlane(tid >> 6), lane = tid & 63, r32 = lane & 31, hi = lane >> 5;
    char* K_lds = lds + LDS_K;
    ATT_STG_INIT();
    ATT_QLOAD(h, qb * QB);
    ATT_SLOAD(h, 0); ATT_VMW(); ATT_SWRITE_K(0);
    __syncthreads();
}
__device__ __forceinline__ void block(const Tensors& T, int h, int qb, int hn, int qbn, char* lds, Seam& S) {
    int tid = threadIdx.x; asm volatile("" : "+v"(tid));
    const int wid = __builtin_amdgcn_readfirstlane(tid >> 6), lane = tid & 63, r32 = lane & 31, hi = lane >> 5;
    const int NT = 4 * qb + 4, nact = 4 * qb + (wid >> 1) + 1;
    char* V_lds = lds; char* K_lds = lds + LDS_K;
    float* ws = (float*)(lds + LDS_WS) + wid * 64; float* li_l = ws, * al_l = ws + 32;
    float m_reg = -1e30f, l_reg = 0; f32x16 o[4] = {};
    ATT_STG_INIT();
    const int vb0 = (int)(uintptr_t)V_lds + v_rd_base(lane);
#define RESC(a) do { if (__any((a) < 1.f)) { if (hi == 0) al_l[r32] = (a); asm volatile("s_waitcnt lgkmcnt(0)" ::: "memory");              \
                     _Pragma("unroll") for (int d_ = 0; d_ < 4; ++d_) _Pragma("unroll") for (int r = 0; r < 16; ++r) o[d_][r] *= al_l[crow(r, hi)]; } } while (0)
#define ACT(t) ((t) < nact)
    f32x16 pA0, pA1, pB0, pB1; float alA, alB; bf16x8 pa0, pa1, pa2, pa3;
    char* qlds = lds + LDS_QR + wid * 4096 + lane * 16;
#pragma unroll
    for (int d0 = 0; d0 < 4; ++d0) *reinterpret_cast<bf16x8*>(qlds + d0 * 1024) = S.qr[8 + d0];
    ATT_SWRITE_V(0); SBAR();
    ATT_SLOAD(h, KVBLK);
    SBAR(); qkt<0>(pA0, pA1, K_lds, r32, hi, S.qr, qlds);
    partialSM(pA0, pA1, m_reg, alA, ACT(0));
    ATT_VMW(); ATT_SWRITE_V(1); ATT_SWRITE_K(1);
    __syncthreads();
#define HALF_STEP(PX0, PX1, alX, PY0, PY1, alY, t, KB, VB, SB) do {                                                      \
        SBAR(); if ((t) + 1 < NT) { ATT_SLOAD(h, ((t) + 1) * KVBLK); SBAR(); }                                           \
        qkt_fsm<KB>(PX0, PX1, K_lds, r32, hi, S.qr, qlds, PY0, PY1, alY, l_reg, pa0, pa1, pa2, pa3); SBAR();             \
        pv_tile<VB>(o, vb0, pa0, pa1, pa2, pa3); partialSM(PX0, PX1, m_reg, alX, ACT(t));                          \
        __syncthreads();                                                                                                  \
        if ((t) + 1 < NT) { ATT_VMW(); ATT_SWRITE_V(SB); ATT_SWRITE_K(SB); }                                             \
        RESC(alX); __syncthreads(); } while (0)
    for (int t = 1; t + 1 < NT; t += 2) {
        HALF_STEP(pB0, pB1, alB, pA0, pA1, alA, t, 1, 0, 0);
        HALF_STEP(pA0, pA1, alA, pB0, pB1, alB, t + 1, 0, 1, 1);
    }
    SBAR(); qkt<1>(pB0, pB1, K_lds, r32, hi, S.qr, qlds); SBAR();
    ATT_QLOAD_N(hn, qbn * QB); SBAR();
    finishSM(pA0, pA1, alA, l_reg, pa0, pa1, pa2, pa3); SBAR();
    pv_tile<0>(o, vb0, pa0, pa1, pa2, pa3);
    partialSM(pB0, pB1, m_reg, alB, ACT(NT - 1)); __syncthreads(); RESC(alB);
    ATT_SLOAD(hn, 0); ATT_QLOAD_R(hn, qbn * QB); SBAR();
    finishSM(pB0, pB1, alB, l_reg, pa0, pa1, pa2, pa3); SBAR(); pv_tile<1>(o, vb0, pa0, pa1, pa2, pa3);
    SBAR(); ATT_VMWN(4); ATT_SWRITE_K(0); SBAR();
    if (hi == 0) li_l[r32] = l_reg; asm volatile("s_waitcnt lgkmcnt(0)" ::: "memory");
    float rli[16];
#pragma unroll
    for (int r = 0; r < 16; ++r) rli[r] = __builtin_amdgcn_rcpf(li_l[crow(r, hi)]);
    const size_t rowb = (size_t)qb * QB + wid * QBLK;
#pragma unroll
    for (int r = 0; r < 16; ++r) { const size_t row = rowb + crow(r, hi);
        const bf16_t* gp = T.PROJ + row * NPROJ + PC_MGATE + h * 128 + r32; bf16_t* op = T.MIXIN + row * DM + 2048 + h * 128 + r32;
#pragma unroll
        for (int d0 = 0; d0 < 4; ++d0) { const float g = bf2f(__builtin_nontemporal_load(gp + d0 * 32)); const float v = o[d0][r] * rli[r] * (g * __builtin_amdgcn_rcpf(1.f + __builtin_amdgcn_exp2f(-1.4426950408889634f * g)));
            const float vn = __shfl_xor(v, 1);
            if ((r32 & 1) == 0) *(unsigned*)(op + d0 * 32) = cvtpk(v, vn); } }
    __syncthreads();
#undef RESC
#undef ACT
#undef HALF_STEP
}
__device__ __forceinline__ void phase(const Tensors& T, char* lds, int vcu, int G) {
    Seam S;
    const int nitems = GH * 16;
    int it = vcu; if (it >= nitems) return;
    int h = it >> 4, s = it & 15, pass = 0;
    prime(T, h, s, lds, S);
    for (;;) {
        const int qb = pass ? 31 - s : s;
        int hn = h, sn = s, passn = pass + 1, itn = it;
        const bool more_pass = pass == 0, more_item = it + G < nitems, last = !more_pass && !more_item;
        if (!more_pass) { passn = 0; itn = more_item ? it + G : it; hn = itn >> 4; sn = itn & 15; }
        const int qbn = last ? qb : (passn ? 31 - sn : sn);
        block(T, h, qb, last ? h : hn, qbn, lds, S);
        if (last) break;
        h = hn; s = sn; pass = passn; it = itn;
    }
}
#undef ATT_KOFF
#undef ATT_VMW
#undef ATT_OPQ
#undef ATT_VMWN
#undef ATT_SLOAD
#undef ATT_STG_INIT
#undef ATT_SWRITE_K
#undef ATT_SWRITE_V
#undef ATT_QLOAD
#undef ATT_QLOAD_N
#undef ATT_QLOAD_R
#undef SBAR
}


namespace glaf {
typedef float f32x16 __attribute__((ext_vector_type(16)));
__device__ __forceinline__ int crow(int r, int hi) { return (r & 3) + 8 * (r >> 2) + 4 * hi; }
typedef float f32x2_t __attribute__((ext_vector_type(2))); typedef __bf16 bf16x2_t __attribute__((ext_vector_type(2)));
__device__ __forceinline__ unsigned cvtpk(float lo, float hi) { f32x2_t v = {lo, hi}; bf16x2_t b = __builtin_convertvector(v, bf16x2_t); return __builtin_bit_cast(unsigned, b); }
__device__ __forceinline__ float log_sigmoid_f(float z) { const float t = __builtin_amdgcn_exp2f(-1.4426950408889634f * fabsf(z)); return fminf(z, 0.f) - 0.6931471805599453f * __builtin_amdgcn_logf(1.f + t); }
__device__ __forceinline__ float exp_f(float v) { return __builtin_amdgcn_exp2f(1.4426950408889634f * v); }
__device__ __forceinline__ float silu_fast(float x) { return x * __builtin_amdgcn_rcpf(1.f + __builtin_amdgcn_exp2f(-1.4426950408889634f * x)); }
template <int CTRL> __device__ __forceinline__ float dpp_add(float v) { return v + __builtin_bit_cast(float, __builtin_amdgcn_update_dpp(0, __builtin_bit_cast(int, v), CTRL, 0xf, 0xf, false)); }
__device__ __forceinline__ float row32_sum(float v) {
    v = dpp_add<0xB1>(v);
    v = dpp_add<0x4E>(v);
    v = dpp_add<0x141>(v);
    v = dpp_add<0x140>(v);
    return v + __shfl_xor(v, 16);
}
__device__ __forceinline__ int v_st(int k, int c) { const int kk = (k & ~0xC) | ((k & 4) << 1) | ((k & 8) >> 1); return ((kk >> 3) * 4 + (c >> 5)) * 512 + ((kk & 7) * 32 + (c & 31)) * 2; }
__device__ __forceinline__ int v_rd_base(int lane) { return ((lane & 3) << 3) | (((lane >> 2) & 3) << 6) | (((lane >> 4) & 1) << 5) | (((lane >> 5) & 1) << 8); }
typedef short s16x4 __attribute__((ext_vector_type(4)));
__device__ __forceinline__ void gla1(const bf16_t* __restrict__ PROJ, const float* __restrict__ THIN, const float* __restrict__ w_up, const float* __restrict__ b_alpha,
                                     bf16_t* __restrict__ KVNb, float* __restrict__ DECAY, float* ldsf, int vcu, int G) {
    int tid = threadIdx.x; asm volatile("" : "+v"(tid));
    const int wave = __builtin_amdgcn_readfirstlane(tid >> 6), lane = tid & 63, r32 = lane & 31, hi = lane >> 5;
    char* wb = (char*)ldsf + wave * 16384;
    float* wl = (float*)(wb + 8192);
    const int vb0 = (int)(uintptr_t)wb + v_rd_base(lane);
    for (int item = vcu * NWAVES + wave; item < NCH * GH; item += G * NWAVES) {
        const int n = item >> 4, h = item & 15, row0 = n * 64;
        bf16x8 kreg[8], vreg[16]; f32x4 treg[4];
#pragma unroll
        for (int i = 0; i < 8; ++i) { const int id = lane + 64 * i; kreg[i] = __builtin_nontemporal_load((const bf16x8*)(PROJ + (size_t)(row0 + (id >> 3)) * NPROJ + PC_GK + h * 64 + (id & 7) * 8)); }
#pragma unroll
        for (int i = 0; i < 4; ++i) { const int id = lane + 64 * i; const float* tp = THIN + (size_t)(row0 + (id >> 2)) * NTHIN + (id & 3) * 4;
            treg[i] = (*(const f32x4*)tp + *(const f32x4*)(tp + (size_t)S * NTHIN)) + (*(const f32x4*)(tp + 2 * (size_t)S * NTHIN) + *(const f32x4*)(tp + 3 * (size_t)S * NTHIN)); }
        float w[16];
#pragma unroll
        for (int r = 0; r < 16; ++r) w[r] = w_up[r * 1024 + h * 64 + lane];
        const float bias = b_alpha[h * 64 + lane];
#pragma unroll
        for (int i = 0; i < 16; ++i) { const int id = lane + 64 * i; vreg[i] = __builtin_nontemporal_load((const bf16x8*)(PROJ + (size_t)(row0 + (id >> 4)) * NPROJ + PC_GV + h * 128 + (id & 15) * 8)); }
#pragma unroll
        for (int i = 0; i < 8; ++i) *(bf16x8*)(wb + (lane + 64 * i) * 16) = kreg[i];
#pragma unroll
        for (int i = 0; i < 4; ++i) *(f32x4*)(wl + (lane + 64 * i) * 4) = treg[i];
        asm volatile("s_waitcnt lgkmcnt(0)" ::: "memory");
        float lc[64]; float cum = 0.f;
#pragma unroll
        for (int f = 0; f < 64; ++f) { float z = bias;
#pragma unroll
            for (int q = 0; q < 4; ++q) { const f32x4 a = *(const f32x4*)(wl + f * 16 + q * 4); z += a[0] * w[4 * q] + a[1] * w[4 * q + 1] + a[2] * w[4 * q + 2] + a[3] * w[4 * q + 3]; }
            cum += log_sigmoid_f(z) * (1.f / 16.f); lc[f] = cum; }
        DECAY[(size_t)item * 64 + lane] = exp_f(cum);
        const bf16_t* kl = (const bf16_t*)wb + lane;
        unsigned pk[32];
#pragma unroll
        for (int i = 0; i < 32; ++i) { const float k0 = bf2f(kl[(2 * i) * 64]) * exp_f(cum - lc[2 * i]), k1 = bf2f(kl[(2 * i + 1) * 64]) * exp_f(cum - lc[2 * i + 1]); pk[i] = cvtpk(k0, k1); }
        u32x4 fa0[4], fa1[4];
#pragma unroll
        for (int s = 0; s < 4; ++s)
#pragma unroll
            for (int i = 0; i < 4; ++i) { auto rr = __builtin_amdgcn_permlane32_swap(pk[8 * s + i], pk[8 * s + 4 + i], false, false); fa0[s][i] = rr[0]; fa1[s][i] = rr[1]; }
        asm volatile("s_waitcnt lgkmcnt(0)" ::: "memory");
#pragma unroll
        for (int i = 0; i < 16; ++i) { const int id = lane + 64 * i; *(bf16x8*)(wb + v_st(id >> 4, (id & 15) * 8)) = vreg[i]; }
        asm volatile("s_waitcnt lgkmcnt(0)" ::: "memory");
        bf16_t* op = KVNb + (size_t)item * 8192;
#define G1_TR(dst, off) asm volatile("ds_read_b64_tr_b16 %0, %1 offset:%2" : "=&v"(dst) : "v"(vb0), "i"(off) : "memory")
#define G1_B(b) do { s16x4 l0, l1, l2, l3, h0, h1, h2, h3; constexpr int b_ = (b) * 512;                                                   \
            G1_TR(l0, b_); G1_TR(h0, b_ + 2048); G1_TR(l1, b_ + 4096); G1_TR(h1, b_ + 6144); G1_TR(l2, b_ + 8192); G1_TR(h2, b_ + 10240); G1_TR(l3, b_ + 12288); G1_TR(h3, b_ + 14336); \
            asm volatile("s_waitcnt lgkmcnt(0)" ::: "memory"); __builtin_amdgcn_sched_barrier(0);                                         \
            const bf16x8 v0 = {l0[0], l0[1], l0[2], l0[3], h0[0], h0[1], h0[2], h0[3]}, v1 = {l1[0], l1[1], l1[2], l1[3], h1[0], h1[1], h1[2], h1[3]};     \
            const bf16x8 v2 = {l2[0], l2[1], l2[2], l2[3], h2[0], h2[1], h2[2], h2[3]}, v3 = {l3[0], l3[1], l3[2], l3[3], h3[0], h3[1], h3[2], h3[3]};     \
            f32x16 a0 = {}, a1 = {};                                                                                                         \
            a0 = __builtin_amdgcn_mfma_f32_32x32x16_bf16(__builtin_bit_cast(bf16x8, fa0[0]), v0, a0, 0, 0, 0); a1 = __builtin_amdgcn_mfma_f32_32x32x16_bf16(__builtin_bit_cast(bf16x8, fa1[0]), v0, a1, 0, 0, 0); \
            a0 = __builtin_amdgcn_mfma_f32_32x32x16_bf16(__builtin_bit_cast(bf16x8, fa0[1]), v1, a0, 0, 0, 0); a1 = __builtin_amdgcn_mfma_f32_32x32x16_bf16(__builtin_bit_cast(bf16x8, fa1[1]), v1, a1, 0, 0, 0); \
            a0 = __builtin_amdgcn_mfma_f32_32x32x16_bf16(__builtin_bit_cast(bf16x8, fa0[2]), v2, a0, 0, 0, 0); a1 = __builtin_amdgcn_mfma_f32_32x32x16_bf16(__builtin_bit_cast(bf16x8, fa1[2]), v2, a1, 0, 0, 0); \
            a0 = __builtin_amdgcn_mfma_f32_32x32x16_bf16(__builtin_bit_cast(bf16x8, fa0[3]), v3, a0, 0, 0, 0); a1 = __builtin_amdgcn_mfma_f32_32x32x16_bf16(__builtin_bit_cast(bf16x8, fa1[3]), v3, a1, 0, 0, 0); \
            bf16_t* orow = op + (32 * (b) + r32) * 64 + 4 * hi;                                       \
            _Pragma("unroll") for (int g_ = 0; g_ < 4; ++g_) {                                                                              \
                u32x2 w0, w1; w0.x = cvtpk(a0[4 * g_], a0[4 * g_ + 1]); w0.y = cvtpk(a0[4 * g_ + 2], a0[4 * g_ + 3]); w1.x = cvtpk(a1[4 * g_], a1[4 * g_ + 1]); w1.y = cvtpk(a1[4 * g_ + 2], a1[4 * g_ + 3]); \
                *(u32x2*)(orow + 8 * g_) = w0; *(u32x2*)(orow + 32 + 8 * g_) = w1; } } while (0)
        G1_B(0); G1_B(1); G1_B(2); G1_B(3);
#undef G1_B
#undef G1_TR
        asm volatile("s_waitcnt lgkmcnt(0)" ::: "memory");
    }
}
__device__ __forceinline__ void gla2(const bf16_t* __restrict__ KVNb, const float* __restrict__ DECAY, bf16_t* __restrict__ SN, int vcu, int G) {
    for (int e = vcu * NT + threadIdx.x; e < GH * 128 * 64; e += G * NT) {
        const int h = e / 8192, dk = e & 63;
        float st = 0.f;
#pragma unroll 16
        for (int n = 0; n < NCH; ++n) { const size_t off = (size_t)n * (GH * 8192) + e; st = DECAY[(size_t)(n * GH + h) * 64 + dk] * st + bf2f(__builtin_nontemporal_load(KVNb + off)); SN[off] = (bf16_t)f2bf(st); }
    }
}
__device__ __forceinline__ void gla3(const bf16_t* __restrict__ PROJ, const bf16_t* __restrict__ SN, const float* __restrict__ g_gla, bf16_t* __restrict__ MIXIN, float* ldsf, int vcu, int G) {
    int tid = threadIdx.x; asm volatile("" : "+v"(tid));
    const int wave = __builtin_amdgcn_readfirstlane(tid >> 6), lane = tid & 63, r32 = lane & 31, hi = lane >> 5;
    char* wb = (char*)ldsf + wave * 16384;
    for (int item = vcu * NWAVES + wave; item < NCH * GH; item += G * NWAVES) {
        const int n = item >> 4, h = item & 15, row0 = n * 64;
        bf16x8 qa[2][4], sb0[4], sb1[4]; float gl[4];
        const bf16_t* sp = SN + ((size_t)item * 128 + r32) * 64 + 8 * hi;
        { bf16x8 greg[16];
#pragma unroll
          for (int i = 0; i < 16; ++i) { const int id = lane + 64 * i; greg[i] = __builtin_nontemporal_load((const bf16x8*)(PROJ + (size_t)(row0 + (id >> 4)) * NPROJ + PC_GGATE + h * 128 + (id & 15) * 8)); }
#pragma unroll
          for (int b = 0; b < 4; ++b) gl[b] = g_gla[32 * b + r32];
#pragma unroll
          for (int fb = 0; fb < 2; ++fb)
#pragma unroll
            for (int s = 0; s < 4; ++s) qa[fb][s] = __builtin_nontemporal_load((const bf16x8*)(PROJ + (size_t)(row0 + 32 * fb + r32) * NPROJ + PC_GQ + h * 64 + 16 * s + 8 * hi));
#pragma unroll
          for (int s = 0; s < 4; ++s) sb0[s] = __builtin_nontemporal_load((const bf16x8*)(sp + 16 * s));
#pragma unroll
          for (int i = 0; i < 16; ++i) *(bf16x8*)(wb + (lane + 64 * i) * 16) = greg[i]; }
        __builtin_amdgcn_sched_barrier(0);
        f32x16 acc[2][4];
#define G3_MM(b, SB) do { _Pragma("unroll") for (int fb = 0; fb < 2; ++fb) { f32x16 a = {};                                                  \
            _Pragma("unroll") for (int s = 0; s < 4; ++s) a = __builtin_amdgcn_mfma_f32_32x32x16_bf16(qa[fb][s], SB[s], a, 0, 0, 0); acc[fb][b] = a; } } while (0)
#define G3_LD(b, SB) do { _Pragma("unroll") for (int s = 0; s < 4; ++s) SB[s] = __builtin_nontemporal_load((const bf16x8*)(sp + (size_t)(32 * (b)) * 64 + 16 * s)); } while (0)
        G3_LD(1, sb1); G3_MM(0, sb0); __builtin_amdgcn_sched_barrier(0);
        G3_LD(2, sb0); G3_MM(1, sb1); __builtin_amdgcn_sched_barrier(0);
        G3_LD(3, sb1); G3_MM(2, sb0); __builtin_amdgcn_sched_barrier(0);
        G3_MM(3, sb1);
#undef G3_MM
#undef G3_LD
        asm volatile("s_waitcnt lgkmcnt(0)" ::: "memory");
#pragma unroll
        for (int fb = 0; fb < 2; ++fb)
#pragma unroll
            for (int r = 0; r < 16; ++r) {
                float ss = (acc[fb][0][r] * acc[fb][0][r] + acc[fb][1][r] * acc[fb][1][r]) + (acc[fb][2][r] * acc[fb][2][r] + acc[fb][3][r] * acc[fb][3][r]);
                ss = row32_sum(ss);
                const float rstd = __builtin_amdgcn_rsqf(ss * (1.f / 128.f) + EPS);
                bf16_t* gp = (bf16_t*)(wb + (32 * fb + crow(r, hi)) * 256) + r32;
#pragma unroll
                for (int b = 0; b < 4; ++b) { const float g = bf2f(gp[32 * b]); const float v = acc[fb][b][r] * rstd * gl[b] * silu_fast(g);
                    gp[32 * b] = (bf16_t)cvtpk(v, 0.f); } }
        asm volatile("s_waitcnt lgkmcnt(0)" ::: "memory");
#pragma unroll
        for (int i = 0; i < 16; ++i) { const int id = lane + 64 * i; *(u32x4*)(MIXIN + (size_t)(row0 + (id >> 4)) * DM + h * 128 + (id & 15) * 8) = *(const u32x4*)(wb + id * 16); }
        asm volatile("s_waitcnt lgkmcnt(0)" ::: "memory");
    }
}
}


struct Args { const void* in[16]; float* out; unsigned char* ws; int ph_lo, ph_hi; };
__global__ void __launch_bounds__(NWAVES * 64, 2) mega_fwd(Args args) {
    extern __shared__ __attribute__((aligned(16))) unsigned char lds[];
    LAS unsigned char* ldsl = (LAS unsigned char*)lds;
    float* ldsf = (float*)lds;
    const int tid = threadIdx.x;
    const int G = gridDim.x; const int bx = blockIdx.x; const int vcu = (G % 8 == 0) ? (bx % 8) * (G / 8) + bx / 8 : bx;
    unsigned char* ws = args.ws;
    const float* x = (const float*)args.in[0]; const float* c = (const float*)args.in[1]; const int* pos = (const int*)args.in[2];
    const float* w_ada = (const float*)args.in[3]; const float* b_ada = (const float*)args.in[4]; const float* g_pre = (const float*)args.in[5]; const float* g_post = (const float*)args.in[6];
    const float* w_in = (const float*)args.in[7]; const float* w_up = (const float*)args.in[8]; const float* b_alpha = (const float*)args.in[9]; const float* g_gla = (const float*)args.in[10];
    const float* g_qn = (const float*)args.in[11]; const float* w_uq = (const float*)args.in[12]; const float* g_kvn = (const float*)args.in[13]; const float* w_ukv = (const float*)args.in[14]; const float* w_out = (const float*)args.in[15];
    float* out = args.out;
    float* MODP = (float*)(ws + WS_MODP); f32x2* ROPE = (f32x2*)(ws + WS_ROPE); float* SSQQ = (float*)(ws + WS_SSQQ); float* SSQKV = (float*)(ws + WS_SSQKV); float* SSQMIX = (float*)(ws + WS_SSQMIX);
    float* DECAY = (float*)(ws + WS_DECAY); float* THIN = (float*)(ws + WS_MIXIN)  ; bf16_t* KR = (bf16_t*)(ws + WS_KR);
    bf16_t* WTALL = (bf16_t*)(ws + WS_WTALL); bf16_t* WTUQ = (bf16_t*)(ws + WS_WTUQ); bf16_t* WTUKV = (bf16_t*)(ws + WS_WTUKV); bf16_t* WTOUT = (bf16_t*)(ws + WS_WTOUT);
    bf16_t* H = (bf16_t*)(ws + WS_H); bf16_t* PROJ = (bf16_t*)(ws + WS_PROJ); bf16_t* Q = (bf16_t*)(ws + WS_Q); bf16_t* KV = (bf16_t*)(ws + WS_KV);
    float* KVN = (float*)(ws + WS_KVN); bf16_t* SN = (bf16_t*)(ws + WS_SN); bf16_t* MIXIN = (bf16_t*)(ws + WS_MIXIN); float* MIX = (float*)(ws + WS_MIX);

    for (int u = tid; u < (LDS_BYTES - LDSCTL_OFF) / 4; u += NWAVES * 64) ((LAS unsigned*)(ldsl + LDSCTL_OFF))[u] = 0u;
    __syncthreads();
    const int lo = args.ph_lo, hi = args.ph_hi;
    unsigned* barw = (unsigned*)(ws + WS_CTL) + CW_BAR + lo * XCD_BAR_WORDS;
    XcdBarrier bar; bar.bar = barw; bar.x = 0; bar.st = nullptr;
    if (hi - lo > 1) bar = xcd_barrier_post(barw, (volatile LAS unsigned*)(ldsl + MISC_OFF) + 8);
#ifndef PH_MASK
#define PH_MASK 0xFF
#endif
#define IN(k) (((PH_MASK >> (k)) & 1) && lo <= (k) && (k) < hi)
#define GRID_BAR(k) do { if (IN(k) && IN((k) + 1)) xcd_barrier(bar); } while (0)
#ifndef REPEAT_MASK
#define REPEAT_MASK 0
#endif
#define REP(b) for (int rep_ = 0; rep_ < 1 + ((REPEAT_MASK >> (b)) & 1); ++rep_)

    if (IN(0)) REP(0) { const P0Args a{w_in, w_uq, w_ukv, w_out, g_qn, g_kvn, c, w_ada, pos, WTALL, WTUQ, WTUKV, WTOUT, MODP, ROPE}; p0_prologue(a, ldsf, vcu, G); }
    GRID_BAR(0);
    if (IN(1)) REP(1) p1_hnorm(x, g_pre, MODP, b_ada, H, ldsf, vcu, G);
    GRID_BAR(1);
    if (IN(2)) REP(2) {
        pg8::Gemm g{H, WTALL, S, NPROJ, DM, DM}; pg8::StaticOrder So; So.init(S, NPROJ, G, bx);
        pg8::EpiProjF E{PROJ, SSQQ, SSQKV};
        pg8::gemm_phase<pg8::EpiProjF, pg8::StaticOrder, true, true>(ldsl, g, So, E);
        thin_gemm(H, WTALL + (size_t)NPROJ * DM, THIN, ldsf, vcu, G);
#ifdef PROBE_THIN2
        for (int r_ = 0; r_ < PROBE_THIN2; ++r_) thin_gemm(H, WTALL + (size_t)NPROJ * DM, THIN, ldsf, vcu, G);
#endif
    }
    GRID_BAR(2);
    if (IN(3)) {
        if (G == 256) {
            REP(3) { pg8::Gemm g{PROJ + PC_MCQ, WTUQ, S, NQ, QRANK, NPROJ}; pg8::SplitOrderQ So; So.init(vcu, G);
              pg8::EpiQF E{Q, SSQQ, ROPE};
              pg8::gemm_phase<pg8::EpiQF, pg8::SplitOrderQ, true, true>(ldsl, g, So, E); }
            REP(3) { pg8::Gemm g{PROJ + PC_MCKV, WTUKV, S, NKV, KVRANK, NPROJ}; pg8::SplitOrderKV So; So.init(vcu, G);
              pg8::EpiKVF E{KV, SSQKV};
              pg8::gemm_phase<pg8::EpiKVF, pg8::SplitOrderKV, true, true>(ldsl, g, So, E); }
        } else {
            { pg8::Gemm g{PROJ + PC_MCQ, WTUQ, S, NQ, QRANK, NPROJ}; pg8::StaticOrder So; So.init(S, NQ, G, bx);
              pg8::EpiQF E{Q, SSQQ, ROPE};
              pg8::gemm_phase<pg8::EpiQF, pg8::StaticOrder, true, true>(ldsl, g, So, E); }
            { pg8::Gemm g{PROJ + PC_MCKV, WTUKV, S, NKV, KVRANK, NPROJ}; pg8::StaticOrder So; So.init(S, NKV, G, bx);
              pg8::EpiKVF E{KV, SSQKV};
              pg8::gemm_phase<pg8::EpiKVF, pg8::StaticOrder, true, true>(ldsl, g, So, E); }
        }
        REP(4) p3_krope(THIN, ROPE, KR, vcu, G);
        REP(4) glaf::gla1(PROJ, THIN, w_up, b_alpha, (bf16_t*)KVN, DECAY, ldsf, vcu, G);
    }
    GRID_BAR(3);
    if (IN(4)) {
        REP(6) glaf::gla2((const bf16_t*)KVN, DECAY, SN, vcu, G);
        REP(5) { const att::Tensors T{Q, KV, KR, PROJ, MIXIN}; att::phase(T, (char*)lds, vcu, G); }
    }
    GRID_BAR(4);
    if (IN(5)) REP(7) glaf::gla3(PROJ, SN, g_gla, MIXIN, ldsf, vcu, G);
    GRID_BAR(5);
    if (IN(6)) REP(8) {
        pg8::Gemm g{MIXIN, WTOUT, S, DM, DM, DM}; pg8::StaticOrder So; So.init(S, DM, G, bx);
        pg8::EpiMixF E{(bf16_t*)MIX, SSQMIX};
        pg8::gemm_phase<pg8::EpiMixF, pg8::StaticOrder, true, true>(ldsl, g, So, E);
    }
    GRID_BAR(6);
    if (IN(7)) { REP(9) p7_final(x, (const bf16_t*)MIX, SSQMIX, g_post, MODP, b_ada, out, ldsf, vcu, G);
        if (hi - lo > 1 && xb_ld(&barw[XB_TMO]) != 0u) { for (int m = vcu * NWAVES + (tid >> 6); m < S; m += G * NWAVES) if ((tid & 63) == 0) out[(size_t)m * DM] = __builtin_nanf(""); } }
#undef IN
#undef GRID_BAR
}


extern "C" void kernel_launch(void* const* d_in, const int* in_sizes, int n_in, void* d_out, int out_size, void* d_ws, size_t ws_size, hipStream_t stream) {
    static int grid = 0;
    if (grid == 0) {
        if (n_in != 16 || in_sizes[0] != S * DM || out_size != S * DM || ws_size < WS_END) { fprintf(stderr, "kernel_launch: unexpected shapes (n_in %d, in0 %d, out %d, ws %zu)\n", n_in, n_in > 0 ? in_sizes[0] : -1, out_size, ws_size); grid = -1; return; }
        int dev = 0, cus = 0, per_cu = 0;
        if (hipGetDevice(&dev) != hipSuccess || hipDeviceGetAttribute(&cus, hipDeviceAttributeMultiprocessorCount, dev) != hipSuccess) { fprintf(stderr, "kernel_launch: device query failed\n"); grid = -1; return; }
        if (hipFuncSetAttribute((const void*)mega_fwd, hipFuncAttributeMaxDynamicSharedMemorySize, LDS_BYTES) != hipSuccess) { fprintf(stderr, "kernel_launch: hipFuncSetAttribute failed\n"); grid = -1; return; }
        if (hipOccupancyMaxActiveBlocksPerMultiprocessor(&per_cu, (const void*)mega_fwd, NWAVES * 64, LDS_BYTES) != hipSuccess || per_cu < 1) fprintf(stderr, "kernel_launch: note: occupancy query reports %d workgroups per CU\n", per_cu);
        (void)hipGetLastError();
        grid = cus;
    }
    if (grid < 0) return;
    (void)hipMemsetAsync((char*)d_ws + WS_CTL, 0, CTL_ZERO_BYTES, stream);
    Args a{};
    for (int i = 0; i < 16; ++i) a.in[i] = d_in[i];
    a.out = (float*)d_out; a.ws = (unsigned char*)d_ws;
    for (int p = 0; p < N_PHASES; ) { int e = p + 1; while (e < N_PHASES && !((CUT_MASK >> (e - 1)) & 1)) ++e;
        a.ph_lo = p; a.ph_hi = e; hipLaunchKernelGGL(mega_fwd, dim3(grid), dim3(NWAVES * 64), LDS_BYTES, stream, a); p = e; }
#ifdef PROBE_ATT_LAUNCH
    (void)hipFuncSetAttribute((const void*)probe_attn, hipFuncAttributeMaxDynamicSharedMemorySize, LDS_BYTES);
    hipLaunchKernelGGL(probe_attn, dim3(grid), dim3(NWAVES * 64), LDS_BYTES, stream, a);
#endif
#ifdef PROBE_PHASE
    a.ph_lo = PROBE_PHASE; a.ph_hi = PROBE_PHASE + 1; hipLaunchKernelGGL(mega_fwd, dim3(grid), dim3(NWAVES * 64), LDS_BYTES, stream, a);
#endif
    const hipError_t le = hipPeekAtLastError();
    if (le != hipSuccess) fprintf(stderr, "kernel_launch: launch failed: %s\n", hipGetErrorName(le));
}
```

```cpp
#include <hip/hip_runtime.h>
#include <cstdio>
#include <cstdint>

typedef unsigned short bf16_t;
typedef short bf16x8 __attribute__((ext_vector_type(8)));
typedef float f32x4 __attribute__((ext_vector_type(4)));
typedef float f32x2 __attribute__((ext_vector_type(2)));
typedef unsigned u32x4 __attribute__((ext_vector_type(4)));
typedef unsigned u32x2 __attribute__((ext_vector_type(2)));

constexpr int S = 8192, DM = 4096, NT = 512, NWAVES = 8;
constexpr int IN_WIDTH = 10320, NPROJ = 10240, NTHIN = 80;
constexpr int PC_GQ = 0, PC_GK = 1024, PC_GV = 2048, PC_GGATE = 4096, PC_MCQ = 6144, PC_MCKV = 7680, PC_MGATE = 8192;
constexpr int NQ = 3072, NKV = 4096, QRANK = 1536, KVRANK = 512;
constexpr int NCH = 128, GH = 16;
constexpr float EPS = 1e-6f;
constexpr float C2 = 0.07216878364870322f * 1.4426950408889634f;

constexpr size_t MiB = 1u << 20;
constexpr size_t WS_CTL = 0, CTL_ZERO_BYTES = 256 * 1024, WS_MODP = 1 * MiB, WS_ROPE = 2 * MiB, WS_SSQQ = 4 * MiB, WS_SSQKV = 5 * MiB, WS_SSQMIX = 6 * MiB, WS_DECAY = 8 * MiB, WS_THIN = 9 * MiB,
                 WS_KR = 12 * MiB, WS_WTALL = 16 * MiB, WS_WTUQ = 97 * MiB, WS_WTUKV = 106 * MiB, WS_WTOUT = 110 * MiB, WS_H = 142 * MiB, WS_PROJ = 206 * MiB,
                 WS_Q = 366 * MiB, WS_KV = 414 * MiB, WS_KVN = 478 * MiB, WS_SN = 542 * MiB, WS_MIXIN = 574 * MiB, WS_MIX = 142 * MiB  , WS_END = 638 * MiB;
constexpr int CW_BAR = 4096;

__device__ __forceinline__ float bf2f(bf16_t b) { return __uint_as_float((unsigned)b << 16); }
__device__ __forceinline__ unsigned f2bf(float f) { unsigned u = __float_as_uint(f); return (u + 0x7fffu + ((u >> 16) & 1u)) >> 16; }
__device__ __forceinline__ unsigned pk2(float lo, float hi) { return f2bf(lo) | (f2bf(hi) << 16); }
__device__ __forceinline__ float silu_f(float x) { return x / (1.f + __expf(-x)); }
__device__ __forceinline__ float wave_sum(float v) {
#pragma unroll
    for (int o = 1; o < 64; o <<= 1) v += __shfl_xor(v, o);
    return v;
}

namespace pg8 {
#define PG8_LAS __attribute__((address_space(3)))
constexpr int BM = 256, BK = 64, HALF = 128, HTB = HALF * BK * 2  , STAGE_BYTES = 8 * HTB, NXCD = 8, WGM = 8;

__host__ __device__ __forceinline__ int lds_byte(int r, int c) { const int st = (r >> 4) * 2 + (c >> 5), rr = r & 15, cc = c & 31, ob = rr * 64 + cc * 2; return st * 1024 + (ob ^ (((ob >> 9) & 1) << 5)); }
__host__ __device__ __forceinline__ void stage_rc(int b, int& R, int& C) { const int st = b / 1024, sb = b % 1024, swz = sb ^ (((sb >> 9) & 1) << 5); R = (st >> 1) * 16 + swz / 64; C = (st & 1) * 32 + (swz % 64) / 2; }
__host__ __device__ __forceinline__ int perm32(int rho) { const int n = rho >> 4, i = rho & 15; return 8 * (i >> 2) + 4 * n + (i & 3); }

struct Unit { int pm, pn; };
struct Gemm { const bf16_t* A; const bf16_t* Bt; int M, N, K, lda; };

struct StaticOrder {
    int nM, nN, nwg, G, c;
    __host__ __device__ void init(int M, int N, int G_, int c_) { nM = M / BM; nN = N / BM; nwg = nM * nN; G = G_; c = c_; }
    __host__ __device__ bool next(int i, Unit& u) const {
        const long L = (long)i * G + c; if (L >= nwg) return false;
        int wgid = (int)L; { const int q = nwg / NXCD, r = nwg % NXCD, xcd = wgid % NXCD, off = wgid / NXCD; wgid = (xcd < r ? xcd * (q + 1) : r * (q + 1) + (xcd - r) * q) + off; }
        const int nig = WGM * nN, gid = wgid / nig, fm = gid * WGM, gsz = (nM - fm) < WGM ? (nM - fm) : WGM;
        u.pm = fm + ((wgid % nig) % gsz); u.pn = (wgid % nig) / gsz; return true;
    }
    __device__ __forceinline__ void a_ready(const Unit&) const {}
    __device__ __forceinline__ void done(const Unit&) const {}
};

struct SplitOrderQ {
    int x, j, ok;
    __host__ __device__ void init(int v, int G) { x = v >> 5; j = v & 31; ok = (G == 256); }
    __host__ __device__ bool next(int i, Unit& u) const {
        if (!ok) return false;
        int idx; if (j < 16) { if (i > 1) return false; idx = 2 * j + i; } else { if (i > 0) return false; idx = 32 + (j - 16); }
        u.pm = 4 * x + idx / 12; u.pn = idx % 12; return true; }
    __device__ __forceinline__ void a_ready(const Unit&) const {}
    __device__ __forceinline__ void done(const Unit&) const {}
};
struct SplitOrderKV {
    int x, j, ok;
    __host__ __device__ void init(int v, int G) { x = v >> 5; j = v & 31; ok = (G == 256); }
    __host__ __device__ bool next(int i, Unit& u) const {
        if (!ok) return false;
        int idx; if (j < 16) { if (i > 0) return false; idx = j; } else { if (i > 2) return false; idx = 16 + 3 * (j - 16) + i; }
        u.pm = 4 * x + (idx >> 4); u.pn = idx & 15; return true; }
    __device__ __forceinline__ void a_ready(const Unit&) const {}
    __device__ __forceinline__ void done(const Unit&) const {}
};

typedef float f32x2_t __attribute__((ext_vector_type(2))); typedef __bf16 bf16x2_t __attribute__((ext_vector_type(2)));
__device__ __forceinline__ unsigned cvt_pk_bf16(float lo, float hi) { f32x2_t v = {lo, hi}; bf16x2_t b = __builtin_convertvector(v, bf16x2_t); return __builtin_bit_cast(unsigned, b); }
__device__ __forceinline__ u32x4 pack8v(f32x4 v0, f32x4 v1) { u32x4 w; w.x = cvt_pk_bf16(v0[0], v0[1]); w.y = cvt_pk_bf16(v0[2], v0[3]); w.z = cvt_pk_bf16(v1[0], v1[1]); w.w = cvt_pk_bf16(v1[2], v1[3]); return w; }
__device__ __forceinline__ float sumsq8(f32x4 a, f32x4 b) { return (a[0] * a[0] + a[1] * a[1]) + (a[2] * a[2] + a[3] * a[3]) + (b[0] * b[0] + b[1] * b[1]) + (b[2] * b[2] + b[3] * b[3]); }

struct EpiProjF {
    static constexpr bool PERM = true, AFTER_DRAIN = false;
    bf16_t* O; float* SSQQ; float* SSQKV;
    __device__ __forceinline__ void operator()(const f32x4 (&acc)[2][2][4][2], const Unit& u, int wr, int wc, int fr, int fq) const {
        const int row0 = u.pm * BM + wr * 64 + fr, col0 = u.pn * BM + wc * 32 + 8 * fq;
        const bool sq = u.pn >= 24 && u.pn < 32;
#pragma unroll
        for (int ai = 0; ai < 2; ++ai)
#pragma unroll
            for (int m = 0; m < 4; ++m) { const int row = row0 + ai * HALF + m * 16; bf16_t* rowp = O + (size_t)row * NPROJ + col0;
#pragma unroll
                for (int bj = 0; bj < 2; ++bj) *(u32x4*)(rowp + bj * HALF) = pack8v(acc[ai][bj][m][0], acc[ai][bj][m][1]);
                if (sq) { float s = sumsq8(acc[ai][0][m][0], acc[ai][0][m][1]) + sumsq8(acc[ai][1][m][0], acc[ai][1][m][1]);
                    s += __shfl_xor(s, 16); s += __shfl_xor(s, 32);
                    if (fq == 0) { if (u.pn < 30) SSQQ[(size_t)row * 24 + (u.pn - 24) * 4 + wc] = s; else SSQKV[(size_t)row * 8 + (u.pn - 30) * 4 + wc] = s; } } }
    }
};
struct EpiQF {
    static constexpr bool PERM = true, AFTER_DRAIN = false;
    bf16_t* O; const float* SSQQ; const f32x2* ROPE;
    __device__ __forceinline__ void operator()(const f32x4 (&acc)[2][2][4][2], const Unit& u, int wr, int wc, int fr, int fq) const {
        const int row0 = u.pm * BM + wr * 64 + fr, col0 = u.pn * BM + wc * 32 + 8 * fq;
        const bool rope = u.pn >= 8;
#pragma unroll
        for (int ai = 0; ai < 2; ++ai)
#pragma unroll
            for (int m = 0; m < 4; ++m) { const int row = row0 + ai * HALF + m * 16;
                const f32x4* sp = (const f32x4*)(SSQQ + (size_t)row * 24); f32x4 t = sp[0];
#pragma unroll
                for (int i = 1; i < 6; ++i) t = t + sp[i];
                const float r = C2 / sqrtf(((t[0] + t[1]) + (t[2] + t[3])) * (1.f / QRANK) + EPS);
                bf16_t* rowp = O + (size_t)row * NQ + col0;
#pragma unroll
                for (int bj = 0; bj < 2; ++bj) { f32x4 v0 = acc[ai][bj][m][0] * r, v1 = acc[ai][bj][m][1] * r;
                    if (rope) { const int i0 = ((col0 + bj * HALF) & 63) >> 1; const f32x4* cp = (const f32x4*)(ROPE + (size_t)row * 32 + i0); const f32x4 c01 = cp[0], c23 = cp[1];
                        const f32x4 w0 = {v0[0] * c01[0] - v0[1] * c01[1], v0[1] * c01[0] + v0[0] * c01[1], v0[2] * c01[2] - v0[3] * c01[3], v0[3] * c01[2] + v0[2] * c01[3]};
                        const f32x4 w1 = {v1[0] * c23[0] - v1[1] * c23[1], v1[1] * c23[0] + v1[0] * c23[1], v1[2] * c23[2] - v1[3] * c23[3], v1[3] * c23[2] + v1[2] * c23[3]};
                        v0 = w0; v1 = w1; }
                    *(u32x4*)(rowp + bj * HALF) = pack8v(v0, v1); } }
    }
};
struct EpiKVF {
    static constexpr bool PERM = true, AFTER_DRAIN = false;
    bf16_t* O; const float* SSQKV;
    __device__ __forceinline__ void operator()(const f32x4 (&acc)[2][2][4][2], const Unit& u, int wr, int wc, int fr, int fq) const {
        const int row0 = u.pm * BM + wr * 64 + fr, col0 = u.pn * BM + wc * 32 + 8 * fq;
#pragma unroll
        for (int ai = 0; ai < 2; ++ai)
#pragma unroll
            for (int m = 0; m < 4; ++m) { const int row = row0 + ai * HALF + m * 16;
                const f32x4* sp = (const f32x4*)(SSQKV + (size_t)row * 8); const f32x4 t = sp[0] + sp[1];
                const float r = 1.0f / sqrtf(((t[0] + t[1]) + (t[2] + t[3])) * (1.f / KVRANK) + EPS);
                bf16_t* rowp = O + (size_t)row * NKV + col0;
#pragma unroll
                for (int bj = 0; bj < 2; ++bj) *(u32x4*)(rowp + bj * HALF) = pack8v(acc[ai][bj][m][0] * r, acc[ai][bj][m][1] * r); }
    }
};
struct EpiMixF {
    static constexpr bool PERM = true, AFTER_DRAIN = false;
    bf16_t* O; float* SSQMIX;
    __device__ __forceinline__ void operator()(const f32x4 (&acc)[2][2][4][2], const Unit& u, int wr, int wc, int fr, int fq) const {
        const int row0 = u.pm * BM + wr * 64 + fr, col0 = u.pn * BM + wc * 32 + 8 * fq;
#pragma unroll
        for (int ai = 0; ai < 2; ++ai)
#pragma unroll
            for (int m = 0; m < 4; ++m) { const int row = row0 + ai * HALF + m * 16; bf16_t* rowp = O + (size_t)row * DM + col0;
#pragma unroll
                for (int bj = 0; bj < 2; ++bj) *(u32x4*)(rowp + bj * HALF) = pack8v(acc[ai][bj][m][0], acc[ai][bj][m][1]);
                float s = sumsq8(acc[ai][0][m][0], acc[ai][0][m][1]) + sumsq8(acc[ai][1][m][0], acc[ai][1][m][1]);
                s += __shfl_xor(s, 16); s += __shfl_xor(s, 32);
                if (fq == 0) SSQMIX[(size_t)row * 64 + u.pn * 4 + wc] = s; }
    }
};

template <class Epi, class Sched, bool ALIGN_EPI = false, bool SP2 = false>
__device__ __forceinline__ void gemm_phase(PG8_LAS unsigned char* lds, const Gemm g, const Sched& S, const Epi& E) {
    const int tid = threadIdx.x, wid = __builtin_amdgcn_readfirstlane(tid >> 6), lane = tid & 63, wr = wid >> 2, wc = wid & 3, fr = lane & 15, fq = lane >> 4;
    const int K = g.K, nt = K / BK;
    unsigned voffA[2], voffB[2];
#pragma unroll
    for (int i = 0; i < 2; ++i) { int R, C; stage_rc(tid * 16 + i * 8192, R, C); const int Rb = Epi::PERM ? ((R & ~31) + perm32(R & 31)) : R;
        voffA[i] = (unsigned)(R * g.lda + C) * 2u; voffB[i] = (unsigned)(Rb * K + C) * 2u; }
    const size_t kstep = (size_t)(BK * 2);
    const size_t hstepA = (size_t)HALF * g.lda * 2, hstepB = (size_t)HALF * K * 2;
    const size_t tstepA = 2 * hstepA, tstepB = 2 * hstepB;
    const unsigned ldsw = (unsigned)wid * 1024u;
    const int aoff = lds_byte(wr * 64 + fr, fq * 8), boff = lds_byte(wc * 32 + fr, fq * 8);
#define PG8_SA(b, h) (((b) * 2 + (h)) * HTB)
#define PG8_SB(b, h) ((4 + (b) * 2 + (h)) * HTB)
#define PG8_STAGE(bufoff, gbase, voff) do { _Pragma("unroll") for (int _i = 0; _i < 2; ++_i) \
        __builtin_amdgcn_global_load_lds((const unsigned*)((const char*)(gbase) + (voff)[_i]), (PG8_LAS unsigned*)(lds + (bufoff) + ldsw + _i * 8192), 16, 0, 0); } while (0)
#define PG8_LDA(dst, b, h) do { _Pragma("unroll") for (int m = 0; m < 4; ++m) _Pragma("unroll") for (int k = 0; k < 2; ++k) dst[m][k] = *(const PG8_LAS bf16x8*)(lds + PG8_SA(b, h) + aoff + m * 2048 + k * 1024); } while (0)
#define PG8_LDB(dst, b, h) do { _Pragma("unroll") for (int n = 0; n < 2; ++n) _Pragma("unroll") for (int k = 0; k < 2; ++k) dst[n][k] = *(const PG8_LAS bf16x8*)(lds + PG8_SB(b, h) + boff + n * 2048 + k * 1024); } while (0)
#define PG8_MMA(ai, bj, At, Bt) do { __builtin_amdgcn_s_setprio(1); _Pragma("unroll") for (int m = 0; m < 4; ++m) _Pragma("unroll") for (int n = 0; n < 2; ++n) _Pragma("unroll") for (int k = 0; k < 2; ++k) \
        acc[ai][bj][m][n] = __builtin_amdgcn_mfma_f32_16x16x32_bf16(Bt[n][k], At[m][k], acc[ai][bj][m][n], 0, 0, 0); __builtin_amdgcn_s_setprio(0); } while (0)
#define PG8_WAIT_V(n) asm volatile("s_waitcnt vmcnt(" #n ")" ::: "memory")
#define PG8_WAIT_L(n) asm volatile("s_waitcnt lgkmcnt(" #n ")" ::: "memory")
#define PG8_BAR __builtin_amdgcn_s_barrier()
#define PG8_SCHED __builtin_amdgcn_sched_barrier(0)
    Unit cur, nxt; int ui = 0;
    if (!S.next(0, cur)) return;
    f32x4 acc[2][2][4][2];
#pragma unroll
    for (int a = 0; a < 2; ++a)
#pragma unroll
        for (int b = 0; b < 2; ++b)
#pragma unroll
            for (int m = 0; m < 4; ++m)
#pragma unroll
                for (int n = 0; n < 2; ++n) acc[a][b][m][n] = (f32x4){0.f, 0.f, 0.f, 0.f};
    bf16x8 At[4][2], B0[2][2], B1[2][2];
    const char* cA = (const char*)g.A + (size_t)cur.pm * tstepA; const char* cB = (const char*)g.Bt + (size_t)cur.pn * tstepB;
    S.a_ready(cur);
    if constexpr (SP2) {
        PG8_STAGE(PG8_SB(0, 0), cB, voffB); PG8_STAGE(PG8_SB(0, 1), cB + hstepB, voffB); PG8_STAGE(PG8_SA(0, 0), cA, voffA); PG8_STAGE(PG8_SA(0, 1), cA + hstepA, voffA);
        if (wr == 1) PG8_BAR;
        PG8_WAIT_V(2); PG8_BAR;
        PG8_STAGE(PG8_SB(1, 0), cB + kstep, voffB); PG8_STAGE(PG8_SA(1, 0), cA + kstep, voffA); PG8_STAGE(PG8_SB(1, 1), cB + hstepB + kstep, voffB);
        PG8_WAIT_V(6); PG8_BAR;
    } else {
        PG8_STAGE(PG8_SB(0, 0), cB, voffB); PG8_STAGE(PG8_SA(0, 0), cA, voffA); PG8_STAGE(PG8_SB(0, 1), cB + hstepB, voffB); PG8_STAGE(PG8_SA(0, 1), cA + hstepA, voffA);
        if (wr == 1) PG8_BAR;
        PG8_WAIT_V(4); PG8_BAR;
        PG8_STAGE(PG8_SB(1, 0), cB + kstep, voffB); PG8_STAGE(PG8_SA(1, 0), cA + kstep, voffA); PG8_STAGE(PG8_SB(1, 1), cB + hstepB + kstep, voffB);
        PG8_WAIT_V(6); PG8_BAR;
    }
    for (;;) {
        const bool has_next = S.next(ui + 1, nxt);
        const char* nA = has_next ? (const char*)g.A + (size_t)nxt.pm * tstepA : cA; const char* nB = has_next ? (const char*)g.Bt + (size_t)nxt.pn * tstepB : cB;
        for (int t = 0; t < nt; t += 2) {
            const bool last = (t == nt - 2);
            const char* a1 = cA + (size_t)(t + 1) * kstep;
            const char* a2 = last ? nA : cA + (size_t)(t + 2) * kstep; const char* b2 = last ? nB : cB + (size_t)(t + 2) * kstep;
            const char* a3 = a2 + kstep; const char* b3 = b2 + kstep;
            if (last && has_next) S.a_ready(nxt);
            if constexpr (SP2) {
            PG8_LDB(B0, 0, 0); PG8_LDB(B1, 0, 1); PG8_SCHED; PG8_LDA(At, 0, 0); PG8_STAGE(PG8_SA(1, 1), a1 + hstepA, voffA);
            PG8_WAIT_V(8); PG8_WAIT_L(0); PG8_BAR; PG8_MMA(0, 0, At, B0); PG8_MMA(0, 1, At, B1); PG8_BAR; PG8_SCHED;
            PG8_LDA(At, 0, 1); PG8_STAGE(PG8_SB(0, 0), b2, voffB); PG8_STAGE(PG8_SB(0, 1), b2 + hstepB, voffB); PG8_STAGE(PG8_SA(0, 0), a2, voffA);
            PG8_WAIT_V(8); PG8_WAIT_L(0); PG8_BAR; PG8_MMA(1, 0, At, B0); PG8_MMA(1, 1, At, B1); PG8_BAR; PG8_SCHED;
            PG8_LDB(B0, 1, 0); PG8_LDB(B1, 1, 1); PG8_SCHED; PG8_LDA(At, 1, 0); PG8_STAGE(PG8_SA(0, 1), a2 + hstepA, voffA);
            PG8_WAIT_V(8); PG8_WAIT_L(0); PG8_BAR; PG8_MMA(0, 0, At, B0); PG8_MMA(0, 1, At, B1); PG8_BAR; PG8_SCHED;
            PG8_LDA(At, 1, 1); PG8_STAGE(PG8_SB(1, 0), b3, voffB); PG8_STAGE(PG8_SB(1, 1), b3 + hstepB, voffB); PG8_STAGE(PG8_SA(1, 0), a3, voffA);
            PG8_WAIT_V(8); PG8_WAIT_L(0); PG8_BAR; PG8_MMA(1, 0, At, B0); PG8_MMA(1, 1, At, B1); PG8_BAR; PG8_SCHED;
            } else {
            PG8_LDB(B0, 0, 0); PG8_SCHED; PG8_LDA(At, 0, 0); PG8_STAGE(PG8_SA(1, 1), a1 + hstepA, voffA);
            PG8_WAIT_L(8); PG8_BAR; PG8_WAIT_L(0); PG8_MMA(0, 0, At, B0); PG8_BAR; PG8_SCHED;
            PG8_LDB(B1, 0, 1); PG8_STAGE(PG8_SB(0, 0), b2, voffB);
            PG8_BAR; PG8_WAIT_L(0); PG8_MMA(0, 1, At, B1); PG8_BAR;
            PG8_LDA(At, 0, 1); PG8_STAGE(PG8_SA(0, 0), a2, voffA);
            PG8_BAR; PG8_WAIT_L(0); PG8_MMA(1, 0, At, B0); PG8_BAR; PG8_SCHED;
            PG8_STAGE(PG8_SB(0, 1), b2 + hstepB, voffB);
            PG8_WAIT_V(6); PG8_BAR; PG8_MMA(1, 1, At, B1); PG8_BAR;
            PG8_LDB(B0, 1, 0); PG8_SCHED; PG8_LDA(At, 1, 0); PG8_STAGE(PG8_SA(0, 1), a2 + hstepA, voffA);
            PG8_WAIT_L(8); PG8_BAR; PG8_WAIT_L(0); PG8_MMA(0, 0, At, B0); PG8_BAR; PG8_SCHED;
            PG8_LDB(B1, 1, 1); PG8_STAGE(PG8_SB(1, 0), b3, voffB);
            PG8_BAR; PG8_WAIT_L(0); PG8_MMA(0, 1, At, B1); PG8_BAR;
            PG8_LDA(At, 1, 1); PG8_STAGE(PG8_SA(1, 0), a3, voffA);
            PG8_BAR; PG8_WAIT_L(0); PG8_MMA(1, 0, At, B0); PG8_BAR; PG8_SCHED;
            PG8_STAGE(PG8_SB(1, 1), b3 + hstepB, voffB);
            PG8_WAIT_V(6); PG8_BAR; PG8_MMA(1, 1, At, B1); PG8_BAR;
            }
        }
        if constexpr (ALIGN_EPI) { if (wr == 0) PG8_BAR; }
        if constexpr (!Epi::AFTER_DRAIN) { E(acc, cur, wr, wc, fr, fq); S.done(cur); }
        if (!has_next) break;
#pragma unroll
        for (int a = 0; a < 2; ++a)
#pragma unroll
            for (int b = 0; b < 2; ++b)
#pragma unroll
                for (int m = 0; m < 4; ++m)
#pragma unroll
                    for (int n = 0; n < 2; ++n) acc[a][b][m][n] = (f32x4){0.f, 0.f, 0.f, 0.f};
        cur = nxt; cA = nA; cB = nB; ++ui;
        if constexpr (ALIGN_EPI) { if (wr == 1) PG8_BAR; }
    }
    PG8_WAIT_V(0);
    if constexpr (!ALIGN_EPI) { if (wr == 0) PG8_BAR; }
    PG8_BAR;
    if constexpr (Epi::AFTER_DRAIN) { E.fused(acc, cur, wr, wc, fr, fq, lds, wid, lane); S.done(cur); }
#undef PG8_SA
#undef PG8_SB
#undef PG8_STAGE
#undef PG8_LDA
#undef PG8_LDB
#undef PG8_MMA
#undef PG8_WAIT_V
#undef PG8_WAIT_L
#undef PG8_BAR
#undef PG8_SCHED
}
}


#define GAS __attribute__((address_space(1)))
#define LAS __attribute__((address_space(3)))
typedef GAS unsigned gu32;
#define RLX_AGENT __ATOMIC_RELAXED, __HIP_MEMORY_SCOPE_AGENT
constexpr int RING_BYTES = 131072;
constexpr int LDSCTL_OFF = RING_BYTES, MISC_OFF = LDSCTL_OFF + 320;
constexpr int LDS_BYTES = 147456;
#ifndef CUT_MASK
#define CUT_MASK 0x00
#endif
constexpr int N_PHASES = 8;

#define XB_TMO      128
#define XB_XCNT(j)  (256  + 64 * (j))
#define XB_XSUB(j)  (1280 + 64 * (j))
#define XB_XGEN(j)  (2304 + 64 * (j))
#define XB_TOP      3328
#define XB_TOPGEN   3392
#define XCD_BAR_WORDS 3456
#define XB_SPIN_CAP (1u << 22)

__device__ __forceinline__ unsigned xb_ld(unsigned* p)              { return __hip_atomic_load(p, __ATOMIC_RELAXED, __HIP_MEMORY_SCOPE_AGENT); }
__device__ __forceinline__ unsigned xb_add(unsigned* p, unsigned v) { return __hip_atomic_fetch_add(p, v, __ATOMIC_RELAXED, __HIP_MEMORY_SCOPE_AGENT); }
__device__ __forceinline__ unsigned xb_xcc_id() { return (unsigned)__builtin_amdgcn_s_getreg((3 << 11) | 20) & 0xFu; }
#define XB_SPIN(cond, bar) do { unsigned _sp = 0; while (cond) { __builtin_amdgcn_s_sleep(1); \
    if ((++_sp & 255u) == 0u) { if (xb_ld(&(bar)[XB_TMO])) break; if (_sp > XB_SPIN_CAP) { atomicAdd(&(bar)[XB_TMO], 1u); break; } } } } while (0)

struct XcdBarrier {
    unsigned* bar; unsigned x;
    volatile LAS unsigned* st;
};

__device__ __forceinline__ XcdBarrier xcd_barrier_post(unsigned* bar, volatile LAS unsigned* st) {
    XcdBarrier b; b.bar = bar; b.x = xb_xcc_id(); b.st = st;
    if (threadIdx.x == 0) (void)xb_add(&bar[XB_XCNT(b.x)], 1u);
    return b;
}
__device__ __forceinline__ void xcd_barrier_complete(unsigned* bar, unsigned x, unsigned& nloc, unsigned& nx) {
    const unsigned G = gridDim.x * gridDim.y * gridDim.z;
    unsigned sum, cnt, mine, sp = 0u;
    for (;;) {
        sum = 0u; cnt = 0u; mine = 0u;
#pragma unroll
        for (unsigned j = 0; j < 16; ++j) { const unsigned c = xb_ld(&bar[XB_XCNT(j)]); sum += c; cnt += (c > 0u) ? 1u : 0u; mine = (j == x) ? c : mine; }
        if (sum == G) break;
        __builtin_amdgcn_s_sleep(1);
        if ((++sp & 255u) == 0u) { if (xb_ld(&bar[XB_TMO])) break; if (sp > XB_SPIN_CAP) { atomicAdd(&bar[XB_TMO], 1u); break; } }
    }
    nloc = mine > 0u ? mine : 1u; nx = cnt > 0u ? cnt : 1u;
}

__device__ __forceinline__ void xcd_barrier(const XcdBarrier& b) {
    asm volatile("s_waitcnt vmcnt(0)" ::: "memory");
    __syncthreads();
    if (threadIdx.x == 0) {
        unsigned* bar = b.bar;
        __builtin_amdgcn_s_waitcnt(0);
        unsigned nloc = b.st[0], nx = b.st[1];
        if (nloc == 0u) { xcd_barrier_complete(bar, b.x, nloc, nx); b.st[0] = nloc; b.st[1] = nx; }
        const unsigned old = xb_add(&bar[XB_XSUB(b.x)], 1u);
        const unsigned gen = old / nloc;
        if (old + 1u == (gen + 1u) * nloc) {
            __builtin_amdgcn_fence(__ATOMIC_RELEASE, "agent");
            asm volatile("s_waitcnt vmcnt(0)" ::: "memory");
            const unsigned og = xb_add(&bar[XB_TOP], 1u);
            const unsigned tg = og / nx;
            if (og + 1u == (tg + 1u) * nx) xb_add(&bar[XB_TOPGEN], 1u);
            else XB_SPIN(xb_ld(&bar[XB_TOPGEN]) == tg, bar);
            __builtin_amdgcn_fence(__ATOMIC_ACQUIRE, "agent");
            xb_add(&bar[XB_XGEN(b.x)], 1u);
            asm volatile("s_waitcnt vmcnt(0)" ::: "memory");
        } else {
            XB_SPIN(xb_ld(&bar[XB_XGEN(b.x)]) == gen, bar);
            __builtin_amdgcn_fence(__ATOMIC_ACQUIRE, "agent");
            asm volatile("s_waitcnt vmcnt(0)" ::: "memory");
        }
    }
    __syncthreads();
}


enum { TM_IN = 0, TM_UQ = 1, TM_UKV = 2, TM_OUT = 3 };
__device__ __forceinline__ int dst_row(int mode, int n) {
    if (mode == TM_IN) {
        if (n < 4096) return n;
        if (n < 4112) return NPROJ + (n - 4096);
        if (n < 6160) return PC_GGATE + (n - 4112);
        if (n < 7696) return PC_MCQ + (n - 6160);
        if (n < 8208) return PC_MCKV + (n - 7696);
        if (n < 8272) { const int p = n - 8208; return NPROJ + 16 + 2 * (p & 31) + (p >> 5); }
        return PC_MGATE + (n - 8272);
    } else if (mode == TM_UQ) {
        const int h = n / 192, d = n % 192;
        if (d < 128) return h * 128 + d;
        const int p = d - 128; return 2048 + h * 64 + 2 * (p & 31) + (p >> 5);
    } else if (mode == TM_UKV) {
        const int h = n / 256, d = n % 256;
        return d < 128 ? h * 128 + d : 2048 + h * 128 + (d - 128);
    } else return n;
}
struct TrMat { const float* W; bf16_t* WT; int K, N, mode, nblk, rsoff; };
__device__ __forceinline__ unsigned cvtpk_rne(float lo, float hi) { unsigned r; asm volatile("v_cvt_pk_bf16_f32 %0, %1, %2" : "=v"(r) : "v"(lo), "v"(hi)); return r; }
constexpr int TR_P = 257, TR_T = 32 * TR_P;
__device__ __forceinline__ void tr_tile_load(const TrMat& t, int tile, int wave, int lane, f32x4 (&v)[8]) {
    const int kb = tile / t.nblk, nb = tile - kb * t.nblk, k0 = 64 * kb, n0 = 256 * nb;
    const bool ok = n0 + 4 * lane < t.N;
    const float* p = t.W + (size_t)(k0 + 8 * wave) * t.N + n0 + 4 * lane;
#pragma unroll
    for (int i = 0; i < 8; ++i) v[i] = ok ? __builtin_nontemporal_load((const f32x4*)(p + (size_t)i * t.N)) : (f32x4){0.f, 0.f, 0.f, 0.f};
}
__device__ __forceinline__ void tr_tile_pack(const TrMat& t, int tile, int wave, int lane, const f32x4 (&v)[8], unsigned* T, const float* rsl) {
    const int kb = tile / t.nblk, nb = tile - kb * t.nblk, k0 = 64 * kb, n0 = 256 * nb;
    const float cs = (t.mode == TM_IN && n0 < 1024) ? 0.125f : 1.f;
    unsigned* d = T + (4 * wave) * TR_P + 4 * lane;
#pragma unroll
    for (int pr = 0; pr < 4; ++pr) { const float s0 = (t.rsoff >= 0 ? rsl[t.rsoff + k0 + 8 * wave + 2 * pr] : 1.f) * cs, s1 = (t.rsoff >= 0 ? rsl[t.rsoff + k0 + 8 * wave + 2 * pr + 1] : 1.f) * cs;
#pragma unroll
        for (int c = 0; c < 4; ++c) d[pr * TR_P + c] = cvtpk_rne(v[2 * pr][c] * s0, v[2 * pr + 1][c] * s1); }
}
__device__ __forceinline__ void tr_tile_store(const TrMat& t, int tile, int wave, int lane, const unsigned* T) {
    const int kb = tile / t.nblk, nb = tile - kb * t.nblk, k0 = 64 * kb, n0 = 256 * nb, q = lane & 7;
#pragma unroll
    for (int j = 0; j < 4; ++j) { const int n = 32 * wave + 8 * j + (lane >> 3); const unsigned* s = T + (4 * q) * TR_P + n;
        if (n0 + n < t.N) { u32x4 o; o.x = s[0]; o.y = s[TR_P]; o.z = s[2 * TR_P]; o.w = s[3 * TR_P];
            *(u32x4*)(t.WT + (size_t)dst_row(t.mode, n0 + n) * t.K + k0 + 8 * q) = o; } }
}
__device__ __forceinline__ float mod_at(const float* __restrict__ MODP, const float* __restrict__ b_ada, int j) {
    float v = b_ada[j];
#pragma unroll
    for (int s = 0; s < 16; ++s) v += MODP[(size_t)s * 12288 + j];
    return v;
}
__device__ __forceinline__ f32x2 cos_sin_f32arg(float ang) {
    const double a = (double)ang;
    const double n = __builtin_rint(a * 0.63661977236758134308);
    double r = __builtin_fma(-n, 1.57079632679489655800e+00, a); r = __builtin_fma(-n, 6.12323399573676603587e-17, r);
    const double r2 = r * r;
    const double sn = r + r * r2 * (-1.0 / 6 + r2 * (1.0 / 120 + r2 * (-1.0 / 5040 + r2 * (1.0 / 362880 + r2 * (-1.0 / 39916800)))));
    const double cs = 1.0 + r2 * (-0.5 + r2 * (1.0 / 24 + r2 * (-1.0 / 720 + r2 * (1.0 / 40320 + r2 * (-1.0 / 3628800 + r2 * (1.0 / 479001600))))));
    const int q = ((int)(long long)n) & 3;
    double co, si;
    if (q == 0) { co = cs; si = sn; } else if (q == 1) { co = -sn; si = cs; } else if (q == 2) { co = -cs; si = -sn; } else { co = sn; si = -cs; }
    return (f32x2){(float)co, (float)si};
}
struct P0Args { const float *w_in, *w_uq, *w_ukv, *w_out, *g_qn, *g_kvn, *c, *w_ada; const int* pos; bf16_t *WTALL, *WTUQ, *WTUKV, *WTOUT; float* MODP; f32x2* ROPE; };
__device__ __forceinline__ void p0_prologue(const P0Args& a, float* ldsf, int vcu, int G) {
    const int tid = threadIdx.x, wave = tid >> 6, lane = tid & 63;
    float* scr = ldsf + wave * (64 * 33); float* sc = ldsf + 8 * 64 * 33;
    for (int i = tid; i < DM; i += NT) sc[i] = silu_f(a.c[i]);
    __syncthreads();
    const int gw = vcu * NWAVES + wave, NGW = G * NWAVES;
    if (G == 256) {
        const int s = vcu >> 4, cset = vcu & 15, kb = s * 256 + wave * 32;
        const float* wp = a.w_ada + (size_t)kb * 12288 + cset * 768 + 4 * lane;
        f32x4 acc0 = {0.f, 0.f, 0.f, 0.f}, acc1 = acc0, acc2 = acc0;
#pragma unroll 8
        for (int k = 0; k < 32; ++k) { const float av = sc[kb + k]; const f32x4* rp = (const f32x4*)(wp + (size_t)k * 12288);
            const f32x4 w0 = __builtin_nontemporal_load(rp), w1 = __builtin_nontemporal_load(rp + 64), w2 = __builtin_nontemporal_load(rp + 128);
            acc0 += av * w0; acc1 += av * w1; acc2 += av * w2; }
        float* red = ldsf + wave * 768 + 4 * lane;
        *(f32x4*)red = acc0; *(f32x4*)(red + 256) = acc1; *(f32x4*)(red + 512) = acc2;
        __syncthreads();
        for (int e = tid; e < 768; e += NT) { float t = 0.f;
#pragma unroll
            for (int w = 0; w < 8; ++w) t += ldsf[w * 768 + e];
            a.MODP[(size_t)s * 12288 + cset * 768 + e] = t; }
        __syncthreads();
    } else
    for (int task = gw; task < 96 * 16; task += NGW) {
        const int g = task % 96, s = task / 96, k0 = s * 256;
        const float* wp = a.w_ada + (size_t)k0 * 12288 + g * 128 + 2 * lane;
        f32x2 acc = {0.f, 0.f};
#pragma unroll 16
        for (int k = 0; k < 256; ++k) { const f32x2 w = __builtin_nontemporal_load((const f32x2*)(wp + (size_t)k * 12288)); const float av = sc[k0 + k]; acc.x += av * w.x; acc.y += av * w.y; }
        *(f32x2*)(a.MODP + (size_t)s * 12288 + g * 128 + 2 * lane) = acc;
    }
    constexpr int T_IN = (DM / 64) * ((IN_WIDTH + 255) / 256), T_UQ = (QRANK / 64) * (NQ / 256), T_UKV = (KVRANK / 64) * (NKV / 256), T_OUT = (DM / 64) * (DM / 256), T_ALL = T_IN + T_UQ + T_UKV + T_OUT;
    const TrMat mIN{a.w_in, a.WTALL, DM, IN_WIDTH, TM_IN, (IN_WIDTH + 255) / 256, -1}, mUQ{a.w_uq, a.WTUQ, QRANK, NQ, TM_UQ, NQ / 256, 0},
                mUKV{a.w_ukv, a.WTUKV, KVRANK, NKV, TM_UKV, NKV / 256, QRANK}, mOUT{a.w_out, a.WTOUT, DM, DM, TM_OUT, DM / 256, -1};
#define TR_PICK(it_, M_, r_) do { r_ = (it_); if (r_ < T_IN) M_ = mIN; else { r_ -= T_IN; if (r_ < T_UQ) M_ = mUQ; else { r_ -= T_UQ; if (r_ < T_UKV) M_ = mUKV; else { r_ -= T_UKV; M_ = mOUT; } } } } while (0)
    __syncthreads();
    for (int i = tid; i < QRANK + KVRANK; i += NT) sc[i] = i < QRANK ? a.g_qn[i] : a.g_kvn[i - QRANK];
    __syncthreads();
    { unsigned* T = (unsigned*)ldsf; f32x4 v[8]; TrMat M = mIN; int r = 0, buf = 0;
      int t = vcu;
      if (t < T_ALL) { TR_PICK(t, M, r); tr_tile_load(M, r, wave, lane, v); }
      for (; t < T_ALL; t += G, buf ^= 1) {
          tr_tile_pack(M, r, wave, lane, v, T + buf * TR_T, sc);
          const TrMat Mc = M; const int rc = r;
          if (t + G < T_ALL) { TR_PICK(t + G, M, r); tr_tile_load(M, r, wave, lane, v); }
          __syncthreads();
          tr_tile_store(Mc, rc, wave, lane, T + buf * TR_T);
      }
      __syncthreads(); }
#undef TR_PICK
    for (int idx = vcu * NT + tid; idx < S * 32; idx += G * NT) {
        const int s = idx >> 5, i = idx & 31;
        const float inv_freq = powf(10000.0f, -(float)i / 32.0f);
        a.ROPE[idx] = cos_sin_f32arg((float)a.pos[s] * inv_freq);
    }
}
__device__ __forceinline__ void p1_hnorm(const float* __restrict__ x, const float* __restrict__ g_pre, const float* __restrict__ MODP, const float* __restrict__ b_ada, bf16_t* __restrict__ H, float* ldsf, int vcu, int G) {
    float* tA = ldsf; float* tB = ldsf + DM;
    { float sh[8], sc[8];
#pragma unroll
      for (int j = 0; j < 8; ++j) { sh[j] = b_ada[threadIdx.x + NT * j]; sc[j] = b_ada[DM + threadIdx.x + NT * j]; }
#pragma unroll 4
      for (int s = 0; s < 16; ++s) { const float* mp = MODP + (size_t)s * 12288 + threadIdx.x;
#pragma unroll
          for (int j = 0; j < 8; ++j) { sh[j] += mp[NT * j]; sc[j] += mp[DM + NT * j]; } }
#pragma unroll
      for (int j = 0; j < 8; ++j) { const int c = threadIdx.x + NT * j; tA[c] = g_pre[c] * (1.f + sc[j]); tB[c] = sh[j]; } }
    __syncthreads();
    const int wave = threadIdx.x >> 6, lane = threadIdx.x & 63;
    for (int m = vcu * NWAVES + wave; m < S; m += G * NWAVES) {
        const f32x4* xr = (const f32x4*)(x + (size_t)m * DM) + lane;
        f32x4 v[16]; float ss = 0.f;
#pragma unroll
        for (int j = 0; j < 16; ++j) { v[j] = __builtin_nontemporal_load(xr + 64 * j); ss += (v[j].x * v[j].x + v[j].y * v[j].y) + (v[j].z * v[j].z + v[j].w * v[j].w); }
        const float rstd = 1.0f / sqrtf(wave_sum(ss) * (1.f / DM) + EPS);
        u32x2* o = (u32x2*)(H + (size_t)m * DM) + lane;
#pragma unroll
        for (int j = 0; j < 16; ++j) { const int c = 256 * j + 4 * lane;
            const f32x4 av = *(const f32x4*)(tA + c), bv = *(const f32x4*)(tB + c);
            u32x2 w; w.x = pk2(v[j].x * rstd * av.x + bv.x, v[j].y * rstd * av.y + bv.y); w.y = pk2(v[j].z * rstd * av.z + bv.z, v[j].w * rstd * av.w + bv.w);
            o[64 * j] = w; }
    }
    __syncthreads();
}
constexpr int TB_PITCH = 544;
constexpr size_t THINP_STRIDE = (size_t)S * NTHIN;
__device__ __forceinline__ void thin_gemm(const bf16_t* __restrict__ H, const bf16_t* __restrict__ WTHIN, float* __restrict__ THINP, float* ldsf, int vcu, int G) {
    const int tid = threadIdx.x, wave = tid >> 6, lane = tid & 63, fr = lane & 15, fq = lane >> 4;
    char* lb = (char*)ldsf;
    const int srow = tid >> 5, sc16 = tid & 31;
    for (int it = vcu; it < 256; it += G) {
        const int rbk = it >> 2, kq = it & 3;
        const bf16_t* ap = H + (size_t)(rbk * 128 + wave * 16 + fr) * DM + kq * 1024 + 8 * fq;
        const bf16_t* bg = WTHIN + (size_t)srow * DM + kq * 1024 + sc16 * 8;
        f32x4 acc[5];
#pragma unroll
        for (int j = 0; j < 5; ++j) acc[j] = (f32x4){0.f, 0.f, 0.f, 0.f};
        bf16x8 st[5], av[8];
#pragma unroll
        for (int i = 0; i < 5; ++i) st[i] = *(const bf16x8*)(bg + (size_t)(16 * i) * DM);
#pragma unroll
        for (int ks = 0; ks < 8; ++ks) av[ks] = *(const bf16x8*)(ap + ks * 32);
#pragma unroll
        for (int i = 0; i < 5; ++i) *(bf16x8*)(lb + (srow + 16 * i) * TB_PITCH + sc16 * 16) = st[i];
        __syncthreads();
#pragma unroll
        for (int c = 0; c < 4; ++c) {
            const char* cur = lb + (c & 1) * (80 * TB_PITCH) + fr * TB_PITCH + fq * 16;
            bf16x8 an[8];
            if (c + 1 < 4) {
#pragma unroll
                for (int i = 0; i < 5; ++i) st[i] = *(const bf16x8*)(bg + (size_t)(16 * i) * DM + (c + 1) * 256);
#pragma unroll
                for (int ks = 0; ks < 8; ++ks) an[ks] = *(const bf16x8*)(ap + (c + 1) * 256 + ks * 32);
            }
            __builtin_amdgcn_sched_barrier(0);
#pragma unroll
            for (int ks = 0; ks < 8; ++ks)
#pragma unroll
                for (int j = 0; j < 5; ++j) { const bf16x8 bv = *(const bf16x8*)(cur + (16 * j) * TB_PITCH + ks * 64); acc[j] = __builtin_amdgcn_mfma_f32_16x16x32_bf16(bv, av[ks], acc[j], 0, 0, 0); }
            __builtin_amdgcn_sched_barrier(0);
            if (c + 1 < 4) {
#pragma unroll
                for (int i = 0; i < 5; ++i) *(bf16x8*)(lb + ((c + 1) & 1) * (80 * TB_PITCH) + (srow + 16 * i) * TB_PITCH + sc16 * 16) = st[i];
#pragma unroll
                for (int ks = 0; ks < 8; ++ks) av[ks] = an[ks];
            }
            __syncthreads();
        }
        float* op = THINP + (size_t)kq * THINP_STRIDE + (size_t)(rbk * 128 + wave * 16 + fr) * NTHIN + 4 * fq;
#pragma unroll
        for (int j = 0; j < 5; ++j) *(f32x4*)(op + 16 * j) = acc[j];
    }
}
__device__ __forceinline__ void p3_krope(const float* __restrict__ THIN, const f32x2* __restrict__ ROPE, bf16_t* __restrict__ KR, int vcu, int G) {
    for (int idx = vcu * NT + threadIdx.x; idx < S * 32; idx += G * NT) { const int m = idx >> 5, i = idx & 31;
        const float* tp = THIN + (size_t)m * NTHIN + 16 + 2 * i;
        const f32x2 xx = (*(const f32x2*)tp + *(const f32x2*)(tp + THINP_STRIDE)) + (*(const f32x2*)(tp + 2 * THINP_STRIDE) + *(const f32x2*)(tp + 3 * THINP_STRIDE)); const f32x2 cs = ROPE[idx];
        *(unsigned*)(KR + (size_t)m * 64 + 2 * i) = pk2(xx.x * cs.x - xx.y * cs.y, xx.y * cs.x + xx.x * cs.y); }
}
__device__ __forceinline__ void p7_final(const float* __restrict__ x, const bf16_t* __restrict__ MIXB, const float* __restrict__ SSQMIX, const float* __restrict__ g_post, const float* __restrict__ MODP, const float* __restrict__ b_ada, float* __restrict__ out, float* ldsf, int vcu, int G) {
    float* tG = ldsf;
    { float gt[8];
#pragma unroll
      for (int j = 0; j < 8; ++j) gt[j] = b_ada[2 * DM + threadIdx.x + NT * j];
#pragma unroll 8
      for (int s = 0; s < 16; ++s) { const float* mp = MODP + (size_t)s * 12288 + 2 * DM + threadIdx.x;
#pragma unroll
          for (int j = 0; j < 8; ++j) gt[j] += mp[NT * j]; }
#pragma unroll
      for (int j = 0; j < 8; ++j) { const int c = threadIdx.x + NT * j; tG[c] = gt[j] * g_post[c]; } }
    __syncthreads();
    const int wave = threadIdx.x >> 6, lane = threadIdx.x & 63;
    for (int m = vcu * NWAVES + wave; m < S; m += G * NWAVES) {
        const float rstd = 1.0f / sqrtf(wave_sum(SSQMIX[(size_t)m * 64 + lane]) * (1.f / DM) + EPS);
        const u32x2* mr = (const u32x2*)(MIXB + (size_t)m * DM) + lane; const f32x4* xr = (const f32x4*)(x + (size_t)m * DM) + lane;
        f32x4* o = (f32x4*)(out + (size_t)m * DM) + lane;
#pragma unroll
        for (int jj = 0; jj < 16; jj += 8) { f32x4 xv[8]; u32x2 mv[8];
#pragma unroll
            for (int j = 0; j < 8; ++j) { xv[j] = __builtin_nontemporal_load(xr + 64 * (jj + j)); mv[j] = __builtin_nontemporal_load(mr + 64 * (jj + j)); }
#pragma unroll
            for (int j = 0; j < 8; ++j) { const f32x4 g = *(const f32x4*)(tG + 256 * (jj + j) + 4 * lane);
                const f32x4 mf = {__uint_as_float(mv[j].x << 16), __uint_as_float(mv[j].x & 0xffff0000u), __uint_as_float(mv[j].y << 16), __uint_as_float(mv[j].y & 0xffff0000u)};
                __builtin_nontemporal_store(xv[j] + g * (mf * rstd), o + 64 * (jj + j)); } }
    }
}


namespace att {
typedef short s16x4 __attribute__((ext_vector_type(4)));
typedef float f32x16 __attribute__((ext_vector_type(16)));
constexpr int NW = 8, QBLK = 32, KVBLK = 64, QB = NW * QBLK;
constexpr int SHM_V = KVBLK * 128 * 2, SHM_K = KVBLK * 384;
constexpr int LDS_K = 2 * SHM_V, LDS_WS = 2 * SHM_V + 2 * SHM_K, LDS_QR = LDS_WS + NW * 64 * 4, LDS_BYTES = LDS_QR + NW * 4096;
constexpr float THR = 6.f;
#define ATT_KOFF(row, c) ((row) * 384 + ((((c) & ~7) | (((c) & 7) ^ (((row) >> 1) & 7))) << 4))
#define SBAR() __builtin_amdgcn_sched_barrier(0)
__device__ __forceinline__ int v_st(int k, int c) { const int kk = (k & ~0xC) | ((k & 4) << 1) | ((k & 8) >> 1); return ((kk >> 3) * 4 + (c >> 5)) * 512 + ((kk & 7) * 32 + (c & 31)) * 2; }
__device__ __forceinline__ int v_rd_base(int lane) { return ((lane & 3) << 3) | (((lane >> 2) & 3) << 6) | (((lane >> 4) & 1) << 5) | (((lane >> 5) & 1) << 8); }
constexpr int v_rd_off(int d0, int ks, int half) { return d0 * 512 + ks * 4096 + half * 2048; }
__device__ __forceinline__ int crow(int r, int hi) { return (r & 3) + 8 * (r >> 2) + 4 * hi; }
typedef float f32x2_t __attribute__((ext_vector_type(2))); typedef __bf16 bf16x2_t __attribute__((ext_vector_type(2)));
__device__ __forceinline__ unsigned cvtpk(float lo, float hi) { f32x2_t v = {lo, hi}; bf16x2_t b = __builtin_convertvector(v, bf16x2_t); return __builtin_bit_cast(unsigned, b); }

__device__ __forceinline__ void partialSM(f32x16& p0, f32x16& p1, float& m_reg, float& alpha, bool act) {
    float pmax = p0[0];
#pragma unroll
    for (int r = 1; r < 16; ++r) pmax = fmaxf(pmax, p0[r]);
#pragma unroll
    for (int r = 0; r < 16; ++r) pmax = fmaxf(pmax, p1[r]);
    { auto rr = __builtin_amdgcn_permlane32_swap(__float_as_uint(pmax), __float_as_uint(pmax), false, false);
      pmax = fmaxf(__uint_as_float(rr[0]), __uint_as_float(rr[1])); }
    if (!act) pmax = -__builtin_inff();
    float mn;
    if (__builtin_expect(__all((pmax - m_reg) <= THR), 1)) { mn = m_reg; alpha = 1.f; }
    else { mn = fmaxf(m_reg, pmax); alpha = __builtin_amdgcn_exp2f(m_reg - mn); m_reg = mn; }
    if (!act) mn = __builtin_inff();
#pragma unroll
    for (int r = 0; r < 16; ++r) p0[r] = p0[r] - mn;
#pragma unroll
    for (int r = 0; r < 16; ++r) p1[r] = p1[r] - mn;
#pragma unroll
    for (int r = 0; r < 16; ++r) p0[r] = __builtin_amdgcn_exp2f(p0[r]);
}
__device__ __forceinline__ void finishSM(f32x16& p0, f32x16& p1, float alpha, float& l_reg, bf16x8& pa0, bf16x8& pa1, bf16x8& pa2, bf16x8& pa3) {
#pragma unroll
    for (int r = 0; r < 16; ++r) p1[r] = __builtin_amdgcn_exp2f(p1[r]);
    float ps = 0;
#pragma unroll
    for (int r = 0; r < 16; ++r) ps += p0[r];
#pragma unroll
    for (int r = 0; r < 16; ++r) ps += p1[r];
    { auto rr = __builtin_amdgcn_permlane32_swap(__float_as_uint(ps), __float_as_uint(ps), false, false);
      ps = __uint_as_float(rr[0]) + __uint_as_float(rr[1]); }
    l_reg = l_reg * alpha + ps;
#define PK4(P, B_, OUT) do { unsigned a0 = cvtpk(P[B_+0], P[B_+1]), a1 = cvtpk(P[B_+2], P[B_+3]);                          \
        unsigned b0 = cvtpk(P[B_+4], P[B_+5]), b1 = cvtpk(P[B_+6], P[B_+7]);                                             \
        auto r0 = __builtin_amdgcn_permlane32_swap(a0, b0, false, false); auto r1 = __builtin_amdgcn_permlane32_swap(a1, b1, false, false); \
        u32x4 w = {r0[0], r1[0], r0[1], r1[1]}; OUT = *reinterpret_cast<bf16x8*>(&w); } while (0)
    PK4(p0, 0, pa0); PK4(p0, 8, pa1); PK4(p1, 0, pa2); PK4(p1, 8, pa3);
#undef PK4
}
template <int KB>
__device__ __forceinline__ void qkt(f32x16& p0, f32x16& p1, const char* K_lds, int r32, int hi, const bf16x8* qr, const char* qlds) {
    p0 = f32x16{}; p1 = f32x16{};
    const char* kb[4];
#pragma unroll
    for (int dd = 0; dd < 4; ++dd) kb[dd] = K_lds + KB * SHM_K + ATT_KOFF(r32, 2 * dd + hi);
#pragma unroll
    for (int d0 = 0; d0 < 12; ++d0) { const char* a = kb[d0 & 3] + (d0 >> 2) * 128;
        bf16x8 b0 = *reinterpret_cast<const bf16x8*>(a);
        bf16x8 b1 = *reinterpret_cast<const bf16x8*>(a + 32 * 384);
        const bf16x8 qf = d0 < 8 ? qr[d0] : *reinterpret_cast<const bf16x8*>(qlds + (d0 - 8) * 1024);
        p0 = __builtin_amdgcn_mfma_f32_32x32x16_bf16(b0, qf, p0, 0, 0, 0);
        p1 = __builtin_amdgcn_mfma_f32_32x32x16_bf16(b1, qf, p1, 0, 0, 0); }
}
template <int KB>
__device__ __forceinline__ void qkt_fsm(f32x16& p0, f32x16& p1, const char* K_lds, int r32, int hi, const bf16x8* qr, const char* qlds,
                                        f32x16& y0, f32x16& y1, float alpha, float& l_reg, bf16x8& pa0, bf16x8& pa1, bf16x8& pa2, bf16x8& pa3) {
    p0 = f32x16{}; p1 = f32x16{};
    const char* kb[4];
#pragma unroll
    for (int dd = 0; dd < 4; ++dd) kb[dd] = K_lds + KB * SHM_K + ATT_KOFF(r32, 2 * dd + hi);
    bf16x8 b0 = *reinterpret_cast<const bf16x8*>(kb[0]), b1 = *reinterpret_cast<const bf16x8*>(kb[0] + 32 * 384);
    float ps = 0.f; unsigned ca0 = 0, ca1 = 0, cb0 = 0, cb1 = 0; u32x4 w0 = {}, w1 = {}, w2 = {}, w3 = {};
#define FS_SUM4(Y, B_) ps += (Y[B_] + Y[B_ + 1]) + (Y[B_ + 2] + Y[B_ + 3])
#define FS_EXP2(B_) do { y1[B_] = __builtin_amdgcn_exp2f(y1[B_]); y1[B_ + 1] = __builtin_amdgcn_exp2f(y1[B_ + 1]); } while (0)
#define FS_PKH0(Y, B_, W) do { ca0 = cvtpk(Y[B_ + 0], Y[B_ + 1]); cb0 = cvtpk(Y[B_ + 4], Y[B_ + 5]); auto r_ = __builtin_amdgcn_permlane32_swap(ca0, cb0, false, false); W[0] = r_[0]; W[2] = r_[1]; } while (0)
#define FS_PKH1(Y, B_, W) do { ca1 = cvtpk(Y[B_ + 2], Y[B_ + 3]); cb1 = cvtpk(Y[B_ + 6], Y[B_ + 7]); auto r_ = __builtin_amdgcn_permlane32_swap(ca1, cb1, false, false); W[1] = r_[0]; W[3] = r_[1]; } while (0)
#pragma unroll
    for (int d0 = 0; d0 < 12; ++d0) {
        bf16x8 n0 = b0, n1 = b1;
        if (d0 < 11) { const char* an = kb[(d0 + 1) & 3] + ((d0 + 1) >> 2) * 128; n0 = *reinterpret_cast<const bf16x8*>(an); n1 = *reinterpret_cast<const bf16x8*>(an + 32 * 384); }
        const bf16x8 qf = d0 < 8 ? qr[d0] : *reinterpret_cast<const bf16x8*>(qlds + (d0 - 8) * 1024);
        p0 = __builtin_amdgcn_mfma_f32_32x32x16_bf16(b0, qf, p0, 0, 0, 0);
        p1 = __builtin_amdgcn_mfma_f32_32x32x16_bf16(b1, qf, p1, 0, 0, 0);
        if (d0 == 0) { FS_SUM4(y0, 0); FS_PKH0(y0, 0, w0); FS_EXP2(0); }
        if (d0 == 1) { FS_SUM4(y0, 4); FS_PKH1(y0, 0, w0); FS_EXP2(2); }
        if (d0 == 2) { FS_SUM4(y0, 8); FS_PKH0(y0, 8, w1); FS_EXP2(4); }
        if (d0 == 3) { FS_SUM4(y0, 12); FS_PKH1(y0, 8, w1); FS_EXP2(6); }
        if (d0 == 4) { FS_EXP2(8); FS_SUM4(y1, 0); }
        if (d0 == 5) { FS_EXP2(10); FS_SUM4(y1, 4); }
        if (d0 == 6) { FS_EXP2(12); FS_PKH0(y1, 0, w2); }
        if (d0 == 7) { FS_EXP2(14); FS_PKH1(y1, 0, w2); }
        if (d0 == 8) { FS_SUM4(y1, 8); FS_PKH0(y1, 8, w3); }
        if (d0 == 9) { FS_SUM4(y1, 12); FS_PKH1(y1, 8, w3); }
        if (d0 == 10) { auto rr = __builtin_amdgcn_permlane32_swap(__float_as_uint(ps), __float_as_uint(ps), false, false); ps = __uint_as_float(rr[0]) + __uint_as_float(rr[1]); l_reg = l_reg * alpha + ps; }
        b0 = n0; b1 = n1;
        SBAR();
    }
    pa0 = __builtin_bit_cast(bf16x8, w0); pa1 = __builtin_bit_cast(bf16x8, w1); pa2 = __builtin_bit_cast(bf16x8, w2); pa3 = __builtin_bit_cast(bf16x8, w3);
#undef FS_SUM4
#undef FS_EXP2
#undef FS_PKH0
#undef FS_PKH1
}
template <int VB>
__device__ __forceinline__ void pv_tile(f32x16* o, int vb0, bf16x8 pa0, bf16x8 pa1, bf16x8 pa2, bf16x8 pa3) {
#define TRRD(dst, off) asm volatile("ds_read_b64_tr_b16 %0, %1 offset:%2" : "=&v"(dst) : "v"(vb0), "i"(off) : "memory")
#define PV_D0(d0) do { s16x4 l0, l1, l2, l3, h0, h1, h2, h3; constexpr int b_ = VB * SHM_V + v_rd_off(d0, 0, 0); \
        TRRD(l0, b_); TRRD(h0, b_ + 2048); TRRD(l1, b_ + 4096); TRRD(h1, b_ + 6144); TRRD(l2, b_ + 8192); TRRD(h2, b_ + 10240); TRRD(l3, b_ + 12288); TRRD(h3, b_ + 14336); \
        asm volatile("s_waitcnt lgkmcnt(0)" ::: "memory"); SBAR(); \
        o[d0] = __builtin_amdgcn_mfma_f32_32x32x16_bf16(pa0, (bf16x8){l0[0], l0[1], l0[2], l0[3], h0[0], h0[1], h0[2], h0[3]}, o[d0], 0, 0, 0);   \
        o[d0] = __builtin_amdgcn_mfma_f32_32x32x16_bf16(pa1, (bf16x8){l1[0], l1[1], l1[2], l1[3], h1[0], h1[1], h1[2], h1[3]}, o[d0], 0, 0, 0);   \
        o[d0] = __builtin_amdgcn_mfma_f32_32x32x16_bf16(pa2, (bf16x8){l2[0], l2[1], l2[2], l2[3], h2[0], h2[1], h2[2], h2[3]}, o[d0], 0, 0, 0);   \
        o[d0] = __builtin_amdgcn_mfma_f32_32x32x16_bf16(pa3, (bf16x8){l3[0], l3[1], l3[2], l3[3], h3[0], h3[1], h3[2], h3[3]}, o[d0], 0, 0, 0); } while (0)
    PV_D0(0); PV_D0(1); PV_D0(2); PV_D0(3);
#undef PV_D0
#undef TRRD
}
struct Tensors { const bf16_t* Q; const bf16_t* KV; const bf16_t* KR; const bf16_t* PROJ; bf16_t* MIXIN; };
struct Seam { bf16x8 qr[12]; bf16x8 st_v0, st_v1, st_k0, st_k1, st_kr; unsigned g_k, g_kr; int l_k0, l_kr, l_v0; };
#define ATT_VMW() asm volatile("s_waitcnt vmcnt(0)" ::: "memory")
#define ATT_VMWN(n) asm volatile("s_waitcnt vmcnt(%0)" :: "i"(n) : "memory")
#define ATT_OPQ(x) asm volatile("" : "+v"(x))
#define ATT_STG_INIT() do { int t_ = tid; ATT_OPQ(t_); const int sr_ = t_ >> 4, sc_ = (t_ & 15) * 8;                                   \
        S.g_k = (unsigned)(sr_ * NKV + sc_) * 2u; S.g_kr = (unsigned)((t_ >> 3) * 64 + (t_ & 7) * 8) * 2u;                            \
        S.l_k0 = ATT_KOFF(t_ >> 4, t_ & 15); S.l_kr = ATT_KOFF(t_ >> 3, 16 + (t_ & 7)); S.l_v0 = v_st(sr_, sc_);                        \
        ATT_OPQ(S.g_k); ATT_OPQ(S.g_kr); ATT_OPQ(S.l_k0); ATT_OPQ(S.l_kr); ATT_OPQ(S.l_v0); } while (0)
#define ATT_SLOAD(h_, k0) do { const char* kvb_ = (const char*)(T.KV + (size_t)(k0) * NKV + (h_) * 128); const char* krb_ = (const char*)(T.KR + (size_t)(k0) * 64);   \
        S.st_v0 = *(const bf16x8*)(kvb_ + 4096 + S.g_k); S.st_v1 = *(const bf16x8*)(kvb_ + (4096 + 32 * NKV * 2) + S.g_k);             \
        S.st_k0 = *(const bf16x8*)(kvb_ + S.g_k); S.st_k1 = *(const bf16x8*)(kvb_ + 32 * NKV * 2 + S.g_k);                              \
        S.st_kr = *(const bf16x8*)(krb_ + S.g_kr); } while (0)
#define ATT_SWRITE_K(bf) do { *(bf16x8*)(K_lds + (bf) * SHM_K + S.l_k0) = S.st_k0; *(bf16x8*)(K_lds + (bf) * SHM_K + S.l_k0 + 32 * 384) = S.st_k1; *(bf16x8*)(K_lds + (bf) * SHM_K + S.l_kr) = S.st_kr; } while (0)
#define ATT_SWRITE_V(bf) do { *(bf16x8*)(V_lds + (bf) * SHM_V + S.l_v0) = S.st_v0; *(bf16x8*)(V_lds + (bf) * SHM_V + S.l_v0 + 8192) = S.st_v1; } while (0)
#define ATT_QLOAD_N(h_, row0_) do { const bf16_t* qp_ = T.Q + (size_t)((row0_) + wid * QBLK + r32) * NQ;                              \
        _Pragma("unroll") for (int d0 = 0; d0 < 8; ++d0) S.qr[d0] = *(const bf16x8*)(qp_ + (h_) * 128 + d0 * 16 + hi * 8); } while (0)
#define ATT_QLOAD_R(h_, row0_) do { const bf16_t* qp_ = T.Q + (size_t)((row0_) + wid * QBLK + r32) * NQ;                              \
        _Pragma("unroll") for (int d0 = 0; d0 < 4; ++d0) S.qr[8 + d0] = *(const bf16x8*)(qp_ + 2048 + (h_) * 64 + d0 * 16 + hi * 8); } while (0)
#define ATT_QLOAD(h_, row0_) do { ATT_QLOAD_N(h_, row0_); ATT_QLOAD_R(h_, row0_); } while (0)

__device__ __forceinline__ void prime(const Tensors& T, int h, int qb, char* lds, Seam& S) {
    int tid = threadIdx.x; asm volatile("" : "+v"(tid));
    const int wid = __builtin_amdgcn_readfirstlane(tid >> 6), lane = tid & 63, r32 = lane & 31, hi = lane >> 5;
    char* K_lds = lds + LDS_K;
    ATT_STG_INIT();
    ATT_QLOAD(h, qb * QB);
    ATT_SLOAD(h, 0); ATT_VMW(); ATT_SWRITE_K(0);
    __syncthreads();
}
__device__ __forceinline__ void block(const Tensors& T, int h, int qb, int hn, int qbn, char* lds, Seam& S) {
    int tid = threadIdx.x; asm volatile("" : "+v"(tid));
    const int wid = __builtin_amdgcn_readfirstlane(tid >> 6), lane = tid & 63, r32 = lane & 31, hi = lane >> 5;
    const int NT = 4 * qb + 4, nact = 4 * qb + (wid >> 1) + 1;
    char* V_lds = lds; char* K_lds = lds + LDS_K;
    float* ws = (float*)(lds + LDS_WS) + wid * 64; float* li_l = ws, * al_l = ws + 32;
    float m_reg = -1e30f, l_reg = 0; f32x16 o[4] = {};
    ATT_STG_INIT();
    const int vb0 = (int)(uintptr_t)V_lds + v_rd_base(lane);
#define RESC(a) do { if (__any((a) < 1.f)) { if (hi == 0) al_l[r32] = (a); asm volatile("s_waitcnt lgkmcnt(0)" ::: "memory");              \
                     _Pragma("unroll") for (int d_ = 0; d_ < 4; ++d_) _Pragma("unroll") for (int r = 0; r < 16; ++r) o[d_][r] *= al_l[crow(r, hi)]; } } while (0)
#define ACT(t) ((t) < nact)
    f32x16 pA0, pA1, pB0, pB1; float alA, alB; bf16x8 pa0, pa1, pa2, pa3;
    char* qlds = lds + LDS_QR + wid * 4096 + lane * 16;
#pragma unroll
    for (int d0 = 0; d0 < 4; ++d0) *reinterpret_cast<bf16x8*>(qlds + d0 * 1024) = S.qr[8 + d0];
    ATT_SWRITE_V(0); SBAR();
    ATT_SLOAD(h, KVBLK);
    SBAR(); qkt<0>(pA0, pA1, K_lds, r32, hi, S.qr, qlds);
    partialSM(pA0, pA1, m_reg, alA, ACT(0));
    ATT_VMW(); ATT_SWRITE_V(1); ATT_SWRITE_K(1);
    __syncthreads();
#define HALF_STEP(PX0, PX1, alX, PY0, PY1, alY, t, KB, VB, SB) do {                                                      \
        SBAR(); if ((t) + 1 < NT) { ATT_SLOAD(h, ((t) + 1) * KVBLK); SBAR(); }                                           \
        qkt_fsm<KB>(PX0, PX1, K_lds, r32, hi, S.qr, qlds, PY0, PY1, alY, l_reg, pa0, pa1, pa2, pa3); SBAR();             \
        pv_tile<VB>(o, vb0, pa0, pa1, pa2, pa3); partialSM(PX0, PX1, m_reg, alX, ACT(t));                          \
        __syncthreads();                                                                                                  \
        if ((t) + 1 < NT) { ATT_VMW(); ATT_SWRITE_V(SB); ATT_SWRITE_K(SB); }                                             \
        RESC(alX); __syncthreads(); } while (0)
    for (int t = 1; t + 1 < NT; t += 2) {
        HALF_STEP(pB0, pB1, alB, pA0, pA1, alA, t, 1, 0, 0);
        HALF_STEP(pA0, pA1, alA, pB0, pB1, alB, t + 1, 0, 1, 1);
    }
    SBAR(); qkt<1>(pB0, pB1, K_lds, r32, hi, S.qr, qlds); SBAR();
    ATT_QLOAD_N(hn, qbn * QB); SBAR();
    finishSM(pA0, pA1, alA, l_reg, pa0, pa1, pa2, pa3); SBAR();
    pv_tile<0>(o, vb0, pa0, pa1, pa2, pa3);
    partialSM(pB0, pB1, m_reg, alB, ACT(NT - 1)); __syncthreads(); RESC(alB);
    ATT_SLOAD(hn, 0); ATT_QLOAD_R(hn, qbn * QB); SBAR();
    finishSM(pB0, pB1, alB, l_reg, pa0, pa1, pa2, pa3); SBAR(); pv_tile<1>(o, vb0, pa0, pa1, pa2, pa3);
    SBAR(); ATT_VMWN(4); ATT_SWRITE_K(0); SBAR();
    if (hi == 0) li_l[r32] = l_reg; asm volatile("s_waitcnt lgkmcnt(0)" ::: "memory");
    float rli[16];
#pragma unroll
    for (int r = 0; r < 16; ++r) rli[r] = __builtin_amdgcn_rcpf(li_l[crow(r, hi)]);
    const size_t rowb = (size_t)qb * QB + wid * QBLK;
#pragma unroll
    for (int r = 0; r < 16; ++r) { const size_t row = rowb + crow(r, hi);
        const bf16_t* gp = T.PROJ + row * NPROJ + PC_MGATE + h * 128 + r32; bf16_t* op = T.MIXIN + row * DM + 2048 + h * 128 + r32;
#pragma unroll
        for (int d0 = 0; d0 < 4; ++d0) { const float g = bf2f(__builtin_nontemporal_load(gp + d0 * 32)); const float v = o[d0][r] * rli[r] * (g * __builtin_amdgcn_rcpf(1.f + __builtin_amdgcn_exp2f(-1.4426950408889634f * g)));
            const float vn = __shfl_xor(v, 1);
            if ((r32 & 1) == 0) *(unsigned*)(op + d0 * 32) = cvtpk(v, vn); } }
    __syncthreads();
#undef RESC
#undef ACT
#undef HALF_STEP
}
__device__ __forceinline__ void phase(const Tensors& T, char* lds, int vcu, int G) {
    Seam S;
    const int nitems = GH * 16;
    int it = vcu; if (it >= nitems) return;
    int h = it >> 4, s = it & 15, pass = 0;
    prime(T, h, s, lds, S);
    for (;;) {
        const int qb = pass ? 31 - s : s;
        int hn = h, sn = s, passn = pass + 1, itn = it;
        const bool more_pass = pass == 0, more_item = it + G < nitems, last = !more_pass && !more_item;
        if (!more_pass) { passn = 0; itn = more_item ? it + G : it; hn = itn >> 4; sn = itn & 15; }
        const int qbn = last ? qb : (passn ? 31 - sn : sn);
        block(T, h, qb, last ? h : hn, qbn, lds, S);
        if (last) break;
        h = hn; s = sn; pass = passn; it = itn;
    }
}
#undef ATT_KOFF
#undef ATT_VMW
#undef ATT_OPQ
#undef ATT_VMWN
#undef ATT_SLOAD
#undef ATT_STG_INIT
#undef ATT_SWRITE_K
#undef ATT_SWRITE_V
#undef ATT_QLOAD
#undef ATT_QLOAD_N
#undef ATT_QLOAD_R
#undef SBAR
}


namespace glaf {
typedef float f32x16 __attribute__((ext_vector_type(16)));
__device__ __forceinline__ int crow(int r, int hi) { return (r & 3) + 8 * (r >> 2) + 4 * hi; }
typedef float f32x2_t __attribute__((ext_vector_type(2))); typedef __bf16 bf16x2_t __attribute__((ext_vector_type(2)));
__device__ __forceinline__ unsigned cvtpk(float lo, float hi) { f32x2_t v = {lo, hi}; bf16x2_t b = __builtin_convertvector(v, bf16x2_t); return __builtin_bit_cast(unsigned, b); }
__device__ __forceinline__ float log_sigmoid_f(float z) { const float t = __builtin_amdgcn_exp2f(-1.4426950408889634f * fabsf(z)); return fminf(z, 0.f) - 0.6931471805599453f * __builtin_amdgcn_logf(1.f + t); }
__device__ __forceinline__ float exp_f(float v) { return __builtin_amdgcn_exp2f(1.4426950408889634f * v); }
__device__ __forceinline__ float silu_fast(float x) { return x * __builtin_amdgcn_rcpf(1.f + __builtin_amdgcn_exp2f(-1.4426950408889634f * x)); }
template <int CTRL> __device__ __forceinline__ float dpp_add(float v) { return v + __builtin_bit_cast(float, __builtin_amdgcn_update_dpp(0, __builtin_bit_cast(int, v), CTRL, 0xf, 0xf, false)); }
__device__ __forceinline__ float row32_sum(float v) {
    v = dpp_add<0xB1>(v);
    v = dpp_add<0x4E>(v);
    v = dpp_add<0x141>(v);
    v = dpp_add<0x140>(v);
    return v + __shfl_xor(v, 16);
}
__device__ __forceinline__ int v_st(int k, int c) { const int kk = (k & ~0xC) | ((k & 4) << 1) | ((k & 8) >> 1); return ((kk >> 3) * 4 + (c >> 5)) * 512 + ((kk & 7) * 32 + (c & 31)) * 2; }
__device__ __forceinline__ int v_rd_base(int lane) { return ((lane & 3) << 3) | (((lane >> 2) & 3) << 6) | (((lane >> 4) & 1) << 5) | (((lane >> 5) & 1) << 8); }
typedef short s16x4 __attribute__((ext_vector_type(4)));
__device__ __forceinline__ void gla1(const bf16_t* __restrict__ PROJ, const float* __restrict__ THIN, const float* __restrict__ w_up, const float* __restrict__ b_alpha,
                                     bf16_t* __restrict__ KVNb, float* __restrict__ DECAY, float* ldsf, int vcu, int G) {
    int tid = threadIdx.x; asm volatile("" : "+v"(tid));
    const int wave = __builtin_amdgcn_readfirstlane(tid >> 6), lane = tid & 63, r32 = lane & 31, hi = lane >> 5;
    char* wb = (char*)ldsf + wave * 16384;
    float* wl = (float*)(wb + 8192);
    const int vb0 = (int)(uintptr_t)wb + v_rd_base(lane);
    for (int item = vcu * NWAVES + wave; item < NCH * GH; item += G * NWAVES) {
        const int n = item >> 4, h = item & 15, row0 = n * 64;
        bf16x8 kreg[8], vreg[16]; f32x4 treg[4];
#pragma unroll
        for (int i = 0; i < 8; ++i) { const int id = lane + 64 * i; kreg[i] = __builtin_nontemporal_load((const bf16x8*)(PROJ + (size_t)(row0 + (id >> 3)) * NPROJ + PC_GK + h * 64 + (id & 7) * 8)); }
#pragma unroll
        for (int i = 0; i < 4; ++i) { const int id = lane + 64 * i; const float* tp = THIN + (size_t)(row0 + (id >> 2)) * NTHIN + (id & 3) * 4;
            treg[i] = (*(const f32x4*)tp + *(const f32x4*)(tp + (size_t)S * NTHIN)) + (*(const f32x4*)(tp + 2 * (size_t)S * NTHIN) + *(const f32x4*)(tp + 3 * (size_t)S * NTHIN)); }
        float w[16];
#pragma unroll
        for (int r = 0; r < 16; ++r) w[r] = w_up[r * 1024 + h * 64 + lane];
        const float bias = b_alpha[h * 64 + lane];
#pragma unroll
        for (int i = 0; i < 16; ++i) { const int id = lane + 64 * i; vreg[i] = __builtin_nontemporal_load((const bf16x8*)(PROJ + (size_t)(row0 + (id >> 4)) * NPROJ + PC_GV + h * 128 + (id & 15) * 8)); }
#pragma unroll
        for (int i = 0; i < 8; ++i) *(bf16x8*)(wb + (lane + 64 * i) * 16) = kreg[i];
#pragma unroll
        for (int i = 0; i < 4; ++i) *(f32x4*)(wl + (lane + 64 * i) * 4) = treg[i];
        asm volatile("s_waitcnt lgkmcnt(0)" ::: "memory");
        float lc[64]; float cum = 0.f;
#pragma unroll
        for (int f = 0; f < 64; ++f) { float z = bias;
#pragma unroll
            for (int q = 0; q < 4; ++q) { const f32x4 a = *(const f32x4*)(wl + f * 16 + q * 4); z += a[0] * w[4 * q] + a[1] * w[4 * q + 1] + a[2] * w[4 * q + 2] + a[3] * w[4 * q + 3]; }
            cum += log_sigmoid_f(z) * (1.f / 16.f); lc[f] = cum; }
        DECAY[(size_t)item * 64 + lane] = exp_f(cum);
        const bf16_t* kl = (const bf16_t*)wb + lane;
        unsigned pk[32];
#pragma unroll
        for (int i = 0; i < 32; ++i) { const float k0 = bf2f(kl[(2 * i) * 64]) * exp_f(cum - lc[2 * i]), k1 = bf2f(kl[(2 * i + 1) * 64]) * exp_f(cum - lc[2 * i + 1]); pk[i] = cvtpk(k0, k1); }
        u32x4 fa0[4], fa1[4];
#pragma unroll
        for (int s = 0; s < 4; ++s)
#pragma unroll
            for (int i = 0; i < 4; ++i) { auto rr = __builtin_amdgcn_permlane32_swap(pk[8 * s + i], pk[8 * s + 4 + i], false, false); fa0[s][i] = rr[0]; fa1[s][i] = rr[1]; }
        asm volatile("s_waitcnt lgkmcnt(0)" ::: "memory");
#pragma unroll
        for (int i = 0; i < 16; ++i) { const int id = lane + 64 * i; *(bf16x8*)(wb + v_st(id >> 4, (id & 15) * 8)) = vreg[i]; }
        asm volatile("s_waitcnt lgkmcnt(0)" ::: "memory");
        bf16_t* op = KVNb + (size_t)item * 8192;
#define G1_TR(dst, off) asm volatile("ds_read_b64_tr_b16 %0, %1 offset:%2" : "=&v"(dst) : "v"(vb0), "i"(off) : "memory")
#define G1_B(b) do { s16x4 l0, l1, l2, l3, h0, h1, h2, h3; constexpr int b_ = (b) * 512;                                                   \
            G1_TR(l0, b_); G1_TR(h0, b_ + 2048); G1_TR(l1, b_ + 4096); G1_TR(h1, b_ + 6144); G1_TR(l2, b_ + 8192); G1_TR(h2, b_ + 10240); G1_TR(l3, b_ + 12288); G1_TR(h3, b_ + 14336); \
            asm volatile("s_waitcnt lgkmcnt(0)" ::: "memory"); __builtin_amdgcn_sched_barrier(0);                                         \
            const bf16x8 v0 = {l0[0], l0[1], l0[2], l0[3], h0[0], h0[1], h0[2], h0[3]}, v1 = {l1[0], l1[1], l1[2], l1[3], h1[0], h1[1], h1[2], h1[3]};     \
            const bf16x8 v2 = {l2[0], l2[1], l2[2], l2[3], h2[0], h2[1], h2[2], h2[3]}, v3 = {l3[0], l3[1], l3[2], l3[3], h3[0], h3[1], h3[2], h3[3]};     \
            f32x16 a0 = {}, a1 = {};                                                                                                         \
            a0 = __builtin_amdgcn_mfma_f32_32x32x16_bf16(__builtin_bit_cast(bf16x8, fa0[0]), v0, a0, 0, 0, 0); a1 = __builtin_amdgcn_mfma_f32_32x32x16_bf16(__builtin_bit_cast(bf16x8, fa1[0]), v0, a1, 0, 0, 0); \
            a0 = __builtin_amdgcn_mfma_f32_32x32x16_bf16(__builtin_bit_cast(bf16x8, fa0[1]), v1, a0, 0, 0, 0); a1 = __builtin_amdgcn_mfma_f32_32x32x16_bf16(__builtin_bit_cast(bf16x8, fa1[1]), v1, a1, 0, 0, 0); \
            a0 = __builtin_amdgcn_mfma_f32_32x32x16_bf16(__builtin_bit_cast(bf16x8, fa0[2]), v2, a0, 0, 0, 0); a1 = __builtin_amdgcn_mfma_f32_32x32x16_bf16(__builtin_bit_cast(bf16x8, fa1[2]), v2, a1, 0, 0, 0); \
            a0 = __builtin_amdgcn_mfma_f32_32x32x16_bf16(__builtin_bit_cast(bf16x8, fa0[3]), v3, a0, 0, 0, 0); a1 = __builtin_amdgcn_mfma_f32_32x32x16_bf16(__builtin_bit_cast(bf16x8, fa1[3]), v3, a1, 0, 0, 0); \
            bf16_t* orow = op + (32 * (b) + r32) * 64 + 4 * hi;                                       \
            _Pragma("unroll") for (int g_ = 0; g_ < 4; ++g_) {                                                                              \
                u32x2 w0, w1; w0.x = cvtpk(a0[4 * g_], a0[4 * g_ + 1]); w0.y = cvtpk(a0[4 * g_ + 2], a0[4 * g_ + 3]); w1.x = cvtpk(a1[4 * g_], a1[4 * g_ + 1]); w1.y = cvtpk(a1[4 * g_ + 2], a1[4 * g_ + 3]); \
                *(u32x2*)(orow + 8 * g_) = w0; *(u32x2*)(orow + 32 + 8 * g_) = w1; } } while (0)
        G1_B(0); G1_B(1); G1_B(2); G1_B(3);
#undef G1_B
#undef G1_TR
        asm volatile("s_waitcnt lgkmcnt(0)" ::: "memory");
    }
}
__device__ __forceinline__ void gla2(const bf16_t* __restrict__ KVNb, const float* __restrict__ DECAY, bf16_t* __restrict__ SN, int vcu, int G) {
    for (int e = vcu * NT + threadIdx.x; e < GH * 128 * 64; e += G * NT) {
        const int h = e / 8192, dk = e & 63;
        float st = 0.f;
#pragma unroll 16
        for (int n = 0; n < NCH; ++n) { const size_t off = (size_t)n * (GH * 8192) + e; st = DECAY[(size_t)(n * GH + h) * 64 + dk] * st + bf2f(__builtin_nontemporal_load(KVNb + off)); SN[off] = (bf16_t)f2bf(st); }
    }
}
__device__ __forceinline__ void gla3(const bf16_t* __restrict__ PROJ, const bf16_t* __restrict__ SN, const float* __restrict__ g_gla, bf16_t* __restrict__ MIXIN, float* ldsf, int vcu, int G) {
    int tid = threadIdx.x; asm volatile("" : "+v"(tid));
    const int wave = __builtin_amdgcn_readfirstlane(tid >> 6), lane = tid & 63, r32 = lane & 31, hi = lane >> 5;
    char* wb = (char*)ldsf + wave * 16384;
    for (int item = vcu * NWAVES + wave; item < NCH * GH; item += G * NWAVES) {
        const int n = item >> 4, h = item & 15, row0 = n * 64;
        bf16x8 qa[2][4], sb0[4], sb1[4]; float gl[4];
        const bf16_t* sp = SN + ((size_t)item * 128 + r32) * 64 + 8 * hi;
        { bf16x8 greg[16];
#pragma unroll
          for (int i = 0; i < 16; ++i) { const int id = lane + 64 * i; greg[i] = __builtin_nontemporal_load((const bf16x8*)(PROJ + (size_t)(row0 + (id >> 4)) * NPROJ + PC_GGATE + h * 128 + (id & 15) * 8)); }
#pragma unroll
          for (int b = 0; b < 4; ++b) gl[b] = g_gla[32 * b + r32];
#pragma unroll
          for (int fb = 0; fb < 2; ++fb)
#pragma unroll
            for (int s = 0; s < 4; ++s) qa[fb][s] = __builtin_nontemporal_load((const bf16x8*)(PROJ + (size_t)(row0 + 32 * fb + r32) * NPROJ + PC_GQ + h * 64 + 16 * s + 8 * hi));
#pragma unroll
          for (int s = 0; s < 4; ++s) sb0[s] = __builtin_nontemporal_load((const bf16x8*)(sp + 16 * s));
#pragma unroll
          for (int i = 0; i < 16; ++i) *(bf16x8*)(wb + (lane + 64 * i) * 16) = greg[i]; }
        __builtin_amdgcn_sched_barrier(0);
        f32x16 acc[2][4];
#define G3_MM(b, SB) do { _Pragma("unroll") for (int fb = 0; fb < 2; ++fb) { f32x16 a = {};                                                  \
            _Pragma("unroll") for (int s = 0; s < 4; ++s) a = __builtin_amdgcn_mfma_f32_32x32x16_bf16(qa[fb][s], SB[s], a, 0, 0, 0); acc[fb][b] = a; } } while (0)
#define G3_LD(b, SB) do { _Pragma("unroll") for (int s = 0; s < 4; ++s) SB[s] = __builtin_nontemporal_load((const bf16x8*)(sp + (size_t)(32 * (b)) * 64 + 16 * s)); } while (0)
        G3_LD(1, sb1); G3_MM(0, sb0); __builtin_amdgcn_sched_barrier(0);
        G3_LD(2, sb0); G3_MM(1, sb1); __builtin_amdgcn_sched_barrier(0);
        G3_LD(3, sb1); G3_MM(2, sb0); __builtin_amdgcn_sched_barrier(0);
        G3_MM(3, sb1);
#undef G3_MM
#undef G3_LD
        asm volatile("s_waitcnt lgkmcnt(0)" ::: "memory");
#pragma unroll
        for (int fb = 0; fb < 2; ++fb)
#pragma unroll
            for (int r = 0; r < 16; ++r) {
                float ss = (acc[fb][0][r] * acc[fb][0][r] + acc[fb][1][r] * acc[fb][1][r]) + (acc[fb][2][r] * acc[fb][2][r] + acc[fb][3][r] * acc[fb][3][r]);
                ss = row32_sum(ss);
                const float rstd = __builtin_amdgcn_rsqf(ss * (1.f / 128.f) + EPS);
                bf16_t* gp = (bf16_t*)(wb + (32 * fb + crow(r, hi)) * 256) + r32;
#pragma unroll
                for (int b = 0; b < 4; ++b) { const float g = bf2f(gp[32 * b]); const float v = acc[fb][b][r] * rstd * gl[b] * silu_fast(g);
                    gp[32 * b] = (bf16_t)cvtpk(v, 0.f); } }
        asm volatile("s_waitcnt lgkmcnt(0)" ::: "memory");
#pragma unroll
        for (int i = 0; i < 16; ++i) { const int id = lane + 64 * i; *(u32x4*)(MIXIN + (size_t)(row0 + (id >> 4)) * DM + h * 128 + (id & 15) * 8) = *(const u32x4*)(wb + id * 16); }
        asm volatile("s_waitcnt lgkmcnt(0)" ::: "memory");
    }
}
}


struct Args { const void* in[16]; float* out; unsigned char* ws; int ph_lo, ph_hi; };
__global__ void __launch_bounds__(NWAVES * 64, 2) mega_fwd(Args args) {
    extern __shared__ __attribute__((aligned(16))) unsigned char lds[];
    LAS unsigned char* ldsl = (LAS unsigned char*)lds;
    float* ldsf = (float*)lds;
    const int tid = threadIdx.x;
    const int G = gridDim.x; const int bx = blockIdx.x; const int vcu = (G % 8 == 0) ? (bx % 8) * (G / 8) + bx / 8 : bx;
    unsigned char* ws = args.ws;
    const float* x = (const float*)args.in[0]; const float* c = (const float*)args.in[1]; const int* pos = (const int*)args.in[2];
    const float* w_ada = (const float*)args.in[3]; const float* b_ada = (const float*)args.in[4]; const float* g_pre = (const float*)args.in[5]; const float* g_post = (const float*)args.in[6];
    const float* w_in = (const float*)args.in[7]; const float* w_up = (const float*)args.in[8]; const float* b_alpha = (const float*)args.in[9]; const float* g_gla = (const float*)args.in[10];
    const float* g_qn = (const float*)args.in[11]; const float* w_uq = (const float*)args.in[12]; const float* g_kvn = (const float*)args.in[13]; const float* w_ukv = (const float*)args.in[14]; const float* w_out = (const float*)args.in[15];
    float* out = args.out;
    float* MODP = (float*)(ws + WS_MODP); f32x2* ROPE = (f32x2*)(ws + WS_ROPE); float* SSQQ = (float*)(ws + WS_SSQQ); float* SSQKV = (float*)(ws + WS_SSQKV); float* SSQMIX = (float*)(ws + WS_SSQMIX);
    float* DECAY = (float*)(ws + WS_DECAY); float* THIN = (float*)(ws + WS_MIXIN)  ; bf16_t* KR = (bf16_t*)(ws + WS_KR);
    bf16_t* WTALL = (bf16_t*)(ws + WS_WTALL); bf16_t* WTUQ = (bf16_t*)(ws + WS_WTUQ); bf16_t* WTUKV = (bf16_t*)(ws + WS_WTUKV); bf16_t* WTOUT = (bf16_t*)(ws + WS_WTOUT);
    bf16_t* H = (bf16_t*)(ws + WS_H); bf16_t* PROJ = (bf16_t*)(ws + WS_PROJ); bf16_t* Q = (bf16_t*)(ws + WS_Q); bf16_t* KV = (bf16_t*)(ws + WS_KV);
    float* KVN = (float*)(ws + WS_KVN); bf16_t* SN = (bf16_t*)(ws + WS_SN); bf16_t* MIXIN = (bf16_t*)(ws + WS_MIXIN); float* MIX = (float*)(ws + WS_MIX);

    for (int u = tid; u < (LDS_BYTES - LDSCTL_OFF) / 4; u += NWAVES * 64) ((LAS unsigned*)(ldsl + LDSCTL_OFF))[u] = 0u;
    __syncthreads();
    const int lo = args.ph_lo, hi = args.ph_hi;
    unsigned* barw = (unsigned*)(ws + WS_CTL) + CW_BAR + lo * XCD_BAR_WORDS;
    XcdBarrier bar; bar.bar = barw; bar.x = 0; bar.st = nullptr;
    if (hi - lo > 1) bar = xcd_barrier_post(barw, (volatile LAS unsigned*)(ldsl + MISC_OFF) + 8);
#ifndef PH_MASK
#define PH_MASK 0xFF
#endif
#define IN(k) (((PH_MASK >> (k)) & 1) && lo <= (k) && (k) < hi)
#define GRID_BAR(k) do { if (IN(k) && IN((k) + 1)) xcd_barrier(bar); } while (0)
#ifndef REPEAT_MASK
#define REPEAT_MASK 0
#endif
#define REP(b) for (int rep_ = 0; rep_ < 1 + ((REPEAT_MASK >> (b)) & 1); ++rep_)

    if (IN(0)) REP(0) { const P0Args a{w_in, w_uq, w_ukv, w_out, g_qn, g_kvn, c, w_ada, pos, WTALL, WTUQ, WTUKV, WTOUT, MODP, ROPE}; p0_prologue(a, ldsf, vcu, G); }
    GRID_BAR(0);
    if (IN(1)) REP(1) p1_hnorm(x, g_pre, MODP, b_ada, H, ldsf, vcu, G);
    GRID_BAR(1);
    if (IN(2)) REP(2) {
        pg8::Gemm g{H, WTALL, S, NPROJ, DM, DM}; pg8::StaticOrder So; So.init(S, NPROJ, G, bx);
        pg8::EpiProjF E{PROJ, SSQQ, SSQKV};
        pg8::gemm_phase<pg8::EpiProjF, pg8::StaticOrder, true, true>(ldsl, g, So, E);
        thin_gemm(H, WTALL + (size_t)NPROJ * DM, THIN, ldsf, vcu, G);
#ifdef PROBE_THIN2
        for (int r_ = 0; r_ < PROBE_THIN2; ++r_) thin_gemm(H, WTALL + (size_t)NPROJ * DM, THIN, ldsf, vcu, G);
#endif
    }
    GRID_BAR(2);
    if (IN(3)) {
        if (G == 256) {
            REP(3) { pg8::Gemm g{PROJ + PC_MCQ, WTUQ, S, NQ, QRANK, NPROJ}; pg8::SplitOrderQ So; So.init(vcu, G);
              pg8::EpiQF E{Q, SSQQ, ROPE};
              pg8::gemm_phase<pg8::EpiQF, pg8::SplitOrderQ, true, true>(ldsl, g, So, E); }
            REP(3) { pg8::Gemm g{PROJ + PC_MCKV, WTUKV, S, NKV, KVRANK, NPROJ}; pg8::SplitOrderKV So; So.init(vcu, G);
              pg8::EpiKVF E{KV, SSQKV};
              pg8::gemm_phase<pg8::EpiKVF, pg8::SplitOrderKV, true, true>(ldsl, g, So, E); }
        } else {
            { pg8::Gemm g{PROJ + PC_MCQ, WTUQ, S, NQ, QRANK, NPROJ}; pg8::StaticOrder So; So.init(S, NQ, G, bx);
              pg8::EpiQF E{Q, SSQQ, ROPE};
              pg8::gemm_phase<pg8::EpiQF, pg8::StaticOrder, true, true>(ldsl, g, So, E); }
            { pg8::Gemm g{PROJ + PC_MCKV, WTUKV, S, NKV, KVRANK, NPROJ}; pg8::StaticOrder So; So.init(S, NKV, G, bx);
              pg8::EpiKVF E{KV, SSQKV};
              pg8::gemm_phase<pg8::EpiKVF, pg8::StaticOrder, true, true>(ldsl, g, So, E); }
        }
        REP(4) p3_krope(THIN, ROPE, KR, vcu, G);
        REP(4) glaf::gla1(PROJ, THIN, w_up, b_alpha, (bf16_t*)KVN, DECAY, ldsf, vcu, G);
    }
    GRID_BAR(3);
    if (IN(4)) {
        REP(6) glaf::gla2((const bf16_t*)KVN, DECAY, SN, vcu, G);
        REP(5) { const att::Tensors T{Q, KV, KR, PROJ, MIXIN}; att::phase(T, (char*)lds, vcu, G); }
    }
    GRID_BAR(4);
    if (IN(5)) REP(7) glaf::gla3(PROJ, SN, g_gla, MIXIN, ldsf, vcu, G);
    GRID_BAR(5);
    if (IN(6)) REP(8) {
        pg8::Gemm g{MIXIN, WTOUT, S, DM, DM, DM}; pg8::StaticOrder So; So.init(S, DM, G, bx);
        pg8::EpiMixF E{(bf16_t*)MIX, SSQMIX};
        pg8::gemm_phase<pg8::EpiMixF, pg8::StaticOrder, true, true>(ldsl, g, So, E);
    }
    GRID_BAR(6);
    if (IN(7)) { REP(9) p7_final(x, (const bf16_t*)MIX, SSQMIX, g_post, MODP, b_ada, out, ldsf, vcu, G);
        if (hi - lo > 1 && xb_ld(&barw[XB_TMO]) != 0u) { for (int m = vcu * NWAVES + (tid >> 6); m < S; m += G * NWAVES) if ((tid & 63) == 0) out[(size_t)m * DM] = __builtin_nanf(""); } }
#undef IN
#undef GRID_BAR
}


extern "C" void kernel_launch(void* const* d_in, const int* in_sizes, int n_in, void* d_out, int out_size, void* d_ws, size_t ws_size, hipStream_t stream) {
    static int grid = 0;
    if (grid == 0) {
        if (n_in != 16 || in_sizes[0] != S * DM || out_size != S * DM || ws_size < WS_END) { fprintf(stderr, "kernel_launch: unexpected shapes (n_in %d, in0 %d, out %d, ws %zu)\n", n_in, n_in > 0 ? in_sizes[0] : -1, out_size, ws_size); grid = -1; return; }
        int dev = 0, cus = 0, per_cu = 0;
        if (hipGetDevice(&dev) != hipSuccess || hipDeviceGetAttribute(&cus, hipDeviceAttributeMultiprocessorCount, dev) != hipSuccess) { fprintf(stderr, "kernel_launch: device query failed\n"); grid = -1; return; }
        if (hipFuncSetAttribute((const void*)mega_fwd, hipFuncAttributeMaxDynamicSharedMemorySize, LDS_BYTES) != hipSuccess) { fprintf(stderr, "kernel_launch: hipFuncSetAttribute failed\n"); grid = -1; return; }
        if (hipOccupancyMaxActiveBlocksPerMultiprocessor(&per_cu, (const void*)mega_fwd, NWAVES * 64, LDS_BYTES) != hipSuccess || per_cu < 1) fprintf(stderr, "kernel_launch: note: occupancy query reports %d workgroups per CU\n", per_cu);
        (void)hipGetLastError();
        grid = cus;
    }
    if (grid < 0) return;
    (void)hipMemsetAsync((char*)d_ws + WS_CTL, 0, CTL_ZERO_BYTES, stream);
    Args a{};
    for (int i = 0; i < 16; ++i) a.in[i] = d_in[i];
    a.out = (float*)d_out; a.ws = (unsigned char*)d_ws;
    for (int p = 0; p < N_PHASES; ) { int e = p + 1; while (e < N_PHASES && !((CUT_MASK >> (e - 1)) & 1)) ++e;
        a.ph_lo = p; a.ph_hi = e; hipLaunchKernelGGL(mega_fwd, dim3(grid), dim3(NWAVES * 64), LDS_BYTES, stream, a); p = e; }
#ifdef PROBE_ATT_LAUNCH
    (void)hipFuncSetAttribute((const void*)probe_attn, hipFuncAttributeMaxDynamicSharedMemorySize, LDS_BYTES);
    hipLaunchKernelGGL(probe_attn, dim3(grid), dim3(NWAVES * 64), LDS_BYTES, stream, a);
#endif
#ifdef PROBE_PHASE
    a.ph_lo = PROBE_PHASE; a.ph_hi = PROBE_PHASE + 1; hipLaunchKernelGGL(mega_fwd, dim3(grid), dim3(NWAVES * 64), LDS_BYTES, stream, a);
#endif
    const hipError_t le = hipPeekAtLastError();
    if (le != hipSuccess) fprintf(stderr, "kernel_launch: launch failed: %s\n", hipGetErrorName(le));
}
```

```cpp
#include <hip/hip_runtime.h>
#include <cstdio>
#include <cstdint>

typedef unsigned short bf16_t;
typedef short bf16x8 __attribute__((ext_vector_type(8)));
typedef float f32x4 __attribute__((ext_vector_type(4)));
typedef float f32x2 __attribute__((ext_vector_type(2)));
typedef unsigned u32x4 __attribute__((ext_vector_type(4)));
typedef unsigned u32x2 __attribute__((ext_vector_type(2)));

constexpr int S = 8192, DM = 4096, NT = 512, NWAVES = 8;
constexpr int IN_WIDTH = 10320, NPROJ = 10240, NTHIN = 80;
constexpr int PC_GQ = 0, PC_GK = 1024, PC_GV = 2048, PC_GGATE = 4096, PC_MCQ = 6144, PC_MCKV = 7680, PC_MGATE = 8192;
constexpr int NQ = 3072, NKV = 4096, QRANK = 1536, KVRANK = 512;
constexpr int PW = 4096, PJ_MCQ = 0, PJ_MCKV = 1536, PJ_MGATE = 2048;
constexpr size_t GT_Q = 0, GT_K = (size_t)16 * 8192 * 64, GT_V = 2 * GT_K, GT_G = GT_V + (size_t)16 * 8192 * 128, GT_END = GT_G + (size_t)16 * 8192 * 128;
constexpr int NCH = 128, GH = 16;
constexpr float EPS = 1e-6f;
constexpr float C2 = 0.07216878364870322f * 1.4426950408889634f;

constexpr size_t MiB = 1u << 20;
constexpr size_t WS_CTL = 0, CTL_ZERO_BYTES = 256 * 1024, WS_MODP = 1 * MiB, WS_ROPE = 2 * MiB, WS_SSQQ = 4 * MiB, WS_SSQKV = 5 * MiB, WS_SSQMIX = 6 * MiB, WS_DECAY = 8 * MiB, WS_THIN = 9 * MiB,
                 WS_KR = 12 * MiB, WS_WTALL = 16 * MiB, WS_WTUQ = 97 * MiB, WS_WTUKV = 106 * MiB, WS_WTOUT = 110 * MiB, WS_H = 142 * MiB, WS_PROJ = 206 * MiB,
                 WS_Q = 366 * MiB, WS_KV = 414 * MiB, WS_KVN = 478 * MiB, WS_SN = 542 * MiB, WS_MIXIN = 574 * MiB, WS_MIX = 142 * MiB  , WS_END = 638 * MiB;
constexpr int CW_BAR = 4096;

__device__ __forceinline__ float bf2f(bf16_t b) { return __uint_as_float((unsigned)b << 16); }
__device__ __forceinline__ unsigned f2bf(float f) { unsigned u = __float_as_uint(f); return (u + 0x7fffu + ((u >> 16) & 1u)) >> 16; }
__device__ __forceinline__ unsigned pk2(float lo, float hi) { return f2bf(lo) | (f2bf(hi) << 16); }
__device__ __forceinline__ float silu_f(float x) { return x / (1.f + __expf(-x)); }
__device__ __forceinline__ float wave_sum(float v) {
#pragma unroll
    for (int o = 1; o < 64; o <<= 1) v += __shfl_xor(v, o);
    return v;
}

namespace pg8 {
#define PG8_LAS __attribute__((address_space(3)))
constexpr int BM = 256, BK = 64, HALF = 128, HTB = HALF * BK * 2  , STAGE_BYTES = 8 * HTB, NXCD = 8, WGM = 8;

__host__ __device__ __forceinline__ int lds_byte(int r, int c) { const int st = (r >> 4) * 2 + (c >> 5), rr = r & 15, cc = c & 31, ob = rr * 64 + cc * 2; return st * 1024 + (ob ^ (((ob >> 9) & 1) << 5)); }
__host__ __device__ __forceinline__ void stage_rc(int b, int& R, int& C) { const int st = b / 1024, sb = b % 1024, swz = sb ^ (((sb >> 9) & 1) << 5); R = (st >> 1) * 16 + swz / 64; C = (st & 1) * 32 + (swz % 64) / 2; }
__host__ __device__ __forceinline__ int perm32(int rho) { const int n = rho >> 4, i = rho & 15; return 8 * (i >> 2) + 4 * n + (i & 3); }

struct Unit { int pm, pn; };
struct Gemm { const bf16_t* A; const bf16_t* Bt; int M, N, K, lda; };

struct StaticOrder {
    int nM, nN, nwg, G, c;
    __host__ __device__ void init(int M, int N, int G_, int c_) { nM = M / BM; nN = N / BM; nwg = nM * nN; G = G_; c = c_; }
    __host__ __device__ bool next(int i, Unit& u) const {
        const long L = (long)i * G + c; if (L >= nwg) return false;
        int wgid = (int)L; { const int q = nwg / NXCD, r = nwg % NXCD, xcd = wgid % NXCD, off = wgid / NXCD; wgid = (xcd < r ? xcd * (q + 1) : r * (q + 1) + (xcd - r) * q) + off; }
        const int nig = WGM * nN, gid = wgid / nig, fm = gid * WGM, gsz = (nM - fm) < WGM ? (nM - fm) : WGM;
        u.pm = fm + ((wgid % nig) % gsz); u.pn = (wgid % nig) / gsz; return true;
    }
    __device__ __forceinline__ void a_ready(const Unit&) const {}
    __device__ __forceinline__ void done(const Unit&) const {}
};

struct SplitOrderQ {
    int x, j, ok;
    __host__ __device__ void init(int v, int G) { x = v >> 5; j = v & 31; ok = (G == 256); }
    __host__ __device__ bool next(int i, Unit& u) const {
        if (!ok) return false;
        int idx; if (j < 16) { if (i > 1) return false; idx = 2 * j + i; } else { if (i > 0) return false; idx = 32 + (j - 16); }
        u.pm = 4 * x + idx / 12; u.pn = idx % 12; return true; }
    __device__ __forceinline__ void a_ready(const Unit&) const {}
    __device__ __forceinline__ void done(const Unit&) const {}
};
struct SplitOrderKV {
    int x, j, ok;
    __host__ __device__ void init(int v, int G) { x = v >> 5; j = v & 31; ok = (G == 256); }
    __host__ __device__ bool next(int i, Unit& u) const {
        if (!ok) return false;
        int idx; if (j < 16) { if (i > 0) return false; idx = j; } else { if (i > 2) return false; idx = 16 + 3 * (j - 16) + i; }
        u.pm = 4 * x + (idx >> 4); u.pn = idx & 15; return true; }
    __device__ __forceinline__ void a_ready(const Unit&) const {}
    __device__ __forceinline__ void done(const Unit&) const {}
};

typedef float f32x2_t __attribute__((ext_vector_type(2))); typedef __bf16 bf16x2_t __attribute__((ext_vector_type(2)));
__device__ __forceinline__ unsigned cvt_pk_bf16(float lo, float hi) { f32x2_t v = {lo, hi}; bf16x2_t b = __builtin_convertvector(v, bf16x2_t); return __builtin_bit_cast(unsigned, b); }
__device__ __forceinline__ u32x4 pack8v(f32x4 v0, f32x4 v1) { u32x4 w; w.x = cvt_pk_bf16(v0[0], v0[1]); w.y = cvt_pk_bf16(v0[2], v0[3]); w.z = cvt_pk_bf16(v1[0], v1[1]); w.w = cvt_pk_bf16(v1[2], v1[3]); return w; }
__device__ __forceinline__ float sumsq8(f32x4 a, f32x4 b) { return (a[0] * a[0] + a[1] * a[1]) + (a[2] * a[2] + a[3] * a[3]) + (b[0] * b[0] + b[1] * b[1]) + (b[2] * b[2] + b[3] * b[3]); }

struct EpiProjF {
    static constexpr bool PERM = true, AFTER_DRAIN = false;
    bf16_t* O; float* SSQQ; float* SSQKV; bf16_t* GT;
    __device__ __forceinline__ void operator()(const f32x4 (&acc)[2][2][4][2], const Unit& u, int wr, int wc, int fr, int fq) const {
        const int row0 = u.pm * BM + wr * 64 + fr, col0 = u.pn * BM + wc * 32 + 8 * fq;
        const bool sq = u.pn >= 24 && u.pn < 32;
        bf16_t* base[2]; int pitch;
#pragma unroll
        for (int bj = 0; bj < 2; ++bj) { const int c = col0 + bj * HALF;
            if (u.pn < 4)       { base[bj] = GT + GT_Q + (size_t)(c >> 6) * S * 64 + (c & 63); pitch = 64; }
            else if (u.pn < 8)  { const int cc = c - PC_GK;    base[bj] = GT + GT_K + (size_t)(cc >> 6) * S * 64 + (cc & 63); pitch = 64; }
            else if (u.pn < 16) { const int cc = c - PC_GV;    base[bj] = GT + GT_V + (size_t)(cc >> 7) * S * 128 + (cc & 127); pitch = 128; }
            else if (u.pn < 24) { const int cc = c - PC_GGATE; base[bj] = GT + GT_G + (size_t)(cc >> 7) * S * 128 + (cc & 127); pitch = 128; }
            else                { base[bj] = O + (c - PC_MCQ); pitch = PW; } }
#pragma unroll
        for (int ai = 0; ai < 2; ++ai)
#pragma unroll
            for (int m = 0; m < 4; ++m) { const int row = row0 + ai * HALF + m * 16;
#pragma unroll
                for (int bj = 0; bj < 2; ++bj) *(u32x4*)(base[bj] + (size_t)row * pitch) = pack8v(acc[ai][bj][m][0], acc[ai][bj][m][1]);
                if (sq) { float s = sumsq8(acc[ai][0][m][0], acc[ai][0][m][1]) + sumsq8(acc[ai][1][m][0], acc[ai][1][m][1]);
                    s += __shfl_xor(s, 16); s += __shfl_xor(s, 32);
                    if (fq == 0) { if (u.pn < 30) SSQQ[(size_t)row * 24 + (u.pn - 24) * 4 + wc] = s; else SSQKV[(size_t)row * 8 + (u.pn - 30) * 4 + wc] = s; } } }
    }
};
struct EpiQF {
    static constexpr bool PERM = true, AFTER_DRAIN = false;
    bf16_t* O; const float* SSQQ; const f32x2* ROPE;
    __device__ __forceinline__ void operator()(const f32x4 (&acc)[2][2][4][2], const Unit& u, int wr, int wc, int fr, int fq) const {
        const int row0 = u.pm * BM + wr * 64 + fr, col0 = u.pn * BM + wc * 32 + 8 * fq;
        const bool rope = u.pn >= 8;
#pragma unroll
        for (int ai = 0; ai < 2; ++ai)
#pragma unroll
            for (int m = 0; m < 4; ++m) { const int row = row0 + ai * HALF + m * 16;
                const f32x4* sp = (const f32x4*)(SSQQ + (size_t)row * 24); f32x4 t = sp[0];
#pragma unroll
                for (int i = 1; i < 6; ++i) t = t + sp[i];
                const float r = C2 / sqrtf(((t[0] + t[1]) + (t[2] + t[3])) * (1.f / QRANK) + EPS);
                bf16_t* rowp = O + (size_t)row * NQ + col0;
#pragma unroll
                for (int bj = 0; bj < 2; ++bj) { f32x4 v0 = acc[ai][bj][m][0] * r, v1 = acc[ai][bj][m][1] * r;
                    if (rope) { const int i0 = ((col0 + bj * HALF) & 63) >> 1; const f32x4* cp = (const f32x4*)(ROPE + (size_t)row * 32 + i0); const f32x4 c01 = cp[0], c23 = cp[1];
                        const f32x4 w0 = {v0[0] * c01[0] - v0[1] * c01[1], v0[1] * c01[0] + v0[0] * c01[1], v0[2] * c01[2] - v0[3] * c01[3], v0[3] * c01[2] + v0[2] * c01[3]};
                        const f32x4 w1 = {v1[0] * c23[0] - v1[1] * c23[1], v1[1] * c23[0] + v1[0] * c23[1], v1[2] * c23[2] - v1[3] * c23[3], v1[3] * c23[2] + v1[2] * c23[3]};
                        v0 = w0; v1 = w1; }
                    *(u32x4*)(rowp + bj * HALF) = pack8v(v0, v1); } }
    }
};
struct EpiKVF {
    static constexpr bool PERM = true, AFTER_DRAIN = false;
    bf16_t* O; const float* SSQKV;
    __device__ __forceinline__ void operator()(const f32x4 (&acc)[2][2][4][2], const Unit& u, int wr, int wc, int fr, int fq) const {
        const int row0 = u.pm * BM + wr * 64 + fr, col0 = u.pn * BM + wc * 32 + 8 * fq;
#pragma unroll
        for (int ai = 0; ai < 2; ++ai)
#pragma unroll
            for (int m = 0; m < 4; ++m) { const int row = row0 + ai * HALF + m * 16;
                const f32x4* sp = (const f32x4*)(SSQKV + (size_t)row * 8); const f32x4 t = sp[0] + sp[1];
                const float r = 1.0f / sqrtf(((t[0] + t[1]) + (t[2] + t[3])) * (1.f / KVRANK) + EPS);
                bf16_t* rowp = O + (size_t)row * NKV + col0;
#pragma unroll
                for (int bj = 0; bj < 2; ++bj) *(u32x4*)(rowp + bj * HALF) = pack8v(acc[ai][bj][m][0] * r, acc[ai][bj][m][1] * r); }
    }
};
struct EpiMixF {
    static constexpr bool PERM = true, AFTER_DRAIN = false;
    bf16_t* O; float* SSQMIX;
    __device__ __forceinline__ void operator()(const f32x4 (&acc)[2][2][4][2], const Unit& u, int wr, int wc, int fr, int fq) const {
        const int row0 = u.pm * BM + wr * 64 + fr, col0 = u.pn * BM + wc * 32 + 8 * fq;
#pragma unroll
        for (int ai = 0; ai < 2; ++ai)
#pragma unroll
            for (int m = 0; m < 4; ++m) { const int row = row0 + ai * HALF + m * 16; bf16_t* rowp = O + (size_t)row * DM + col0;
#pragma unroll
                for (int bj = 0; bj < 2; ++bj) *(u32x4*)(rowp + bj * HALF) = pack8v(acc[ai][bj][m][0], acc[ai][bj][m][1]);
                float s = sumsq8(acc[ai][0][m][0], acc[ai][0][m][1]) + sumsq8(acc[ai][1][m][0], acc[ai][1][m][1]);
                s += __shfl_xor(s, 16); s += __shfl_xor(s, 32);
                if (fq == 0) SSQMIX[(size_t)row * 64 + u.pn * 4 + wc] = s; }
    }
};

template <class Epi, class Sched, bool ALIGN_EPI = false, bool SP2 = false>
__device__ __forceinline__ void gemm_phase(PG8_LAS unsigned char* lds, const Gemm g, const Sched& S, const Epi& E) {
    const int tid = threadIdx.x, wid = __builtin_amdgcn_readfirstlane(tid >> 6), lane = tid & 63, wr = wid >> 2, wc = wid & 3, fr = lane & 15, fq = lane >> 4;
    const int K = g.K, nt = K / BK;
    unsigned voffA[2], voffB[2];
#pragma unroll
    for (int i = 0; i < 2; ++i) { int R, C; stage_rc(tid * 16 + i * 8192, R, C); const int Rb = Epi::PERM ? ((R & ~31) + perm32(R & 31)) : R;
        voffA[i] = (unsigned)(R * g.lda + C) * 2u; voffB[i] = (unsigned)(Rb * K + C) * 2u; }
    const size_t kstep = (size_t)(BK * 2);
    const size_t hstepA = (size_t)HALF * g.lda * 2, hstepB = (size_t)HALF * K * 2;
    const size_t tstepA = 2 * hstepA, tstepB = 2 * hstepB;
    const unsigned ldsw = (unsigned)wid * 1024u;
    const int aoff = lds_byte(wr * 64 + fr, fq * 8), boff = lds_byte(wc * 32 + fr, fq * 8);
#define PG8_SA(b, h) (((b) * 2 + (h)) * HTB)
#define PG8_SB(b, h) ((4 + (b) * 2 + (h)) * HTB)
#define PG8_STAGE(bufoff, gbase, voff) do { _Pragma("unroll") for (int _i = 0; _i < 2; ++_i) \
        __builtin_amdgcn_global_load_lds((const unsigned*)((const char*)(gbase) + (voff)[_i]), (PG8_LAS unsigned*)(lds + (bufoff) + ldsw + _i * 8192), 16, 0, 0); } while (0)
#define PG8_LDA(dst, b, h) do { _Pragma("unroll") for (int m = 0; m < 4; ++m) _Pragma("unroll") for (int k = 0; k < 2; ++k) dst[m][k] = *(const PG8_LAS bf16x8*)(lds + PG8_SA(b, h) + aoff + m * 2048 + k * 1024); } while (0)
#define PG8_LDB(dst, b, h) do { _Pragma("unroll") for (int n = 0; n < 2; ++n) _Pragma("unroll") for (int k = 0; k < 2; ++k) dst[n][k] = *(const PG8_LAS bf16x8*)(lds + PG8_SB(b, h) + boff + n * 2048 + k * 1024); } while (0)
#define PG8_MMA(ai, bj, At, Bt) do { __builtin_amdgcn_s_setprio(1); _Pragma("unroll") for (int m = 0; m < 4; ++m) _Pragma("unroll") for (int n = 0; n < 2; ++n) _Pragma("unroll") for (int k = 0; k < 2; ++k) \
        acc[ai][bj][m][n] = __builtin_amdgcn_mfma_f32_16x16x32_bf16(Bt[n][k], At[m][k], acc[ai][bj][m][n], 0, 0, 0); __builtin_amdgcn_s_setprio(0); } while (0)
#define PG8_WAIT_V(n) asm volatile("s_waitcnt vmcnt(" #n ")" ::: "memory")
#define PG8_WAIT_L(n) asm volatile("s_waitcnt lgkmcnt(" #n ")" ::: "memory")
#define PG8_BAR __builtin_amdgcn_s_barrier()
#define PG8_SCHED __builtin_amdgcn_sched_barrier(0)
    Unit cur, nxt; int ui = 0;
    if (!S.next(0, cur)) return;
    f32x4 acc[2][2][4][2];
#pragma unroll
    for (int a = 0; a < 2; ++a)
#pragma unroll
        for (int b = 0; b < 2; ++b)
#pragma unroll
            for (int m = 0; m < 4; ++m)
#pragma unroll
                for (int n = 0; n < 2; ++n) acc[a][b][m][n] = (f32x4){0.f, 0.f, 0.f, 0.f};
    bf16x8 At[4][2], B0[2][2], B1[2][2];
    const char* cA = (const char*)g.A + (size_t)cur.pm * tstepA; const char* cB = (const char*)g.Bt + (size_t)cur.pn * tstepB;
    S.a_ready(cur);
    if constexpr (SP2) {
        PG8_STAGE(PG8_SB(0, 0), cB, voffB); PG8_STAGE(PG8_SB(0, 1), cB + hstepB, voffB); PG8_STAGE(PG8_SA(0, 0), cA, voffA); PG8_STAGE(PG8_SA(0, 1), cA + hstepA, voffA);
        if (wr == 1) PG8_BAR;
        PG8_WAIT_V(2); PG8_BAR;
        PG8_STAGE(PG8_SB(1, 0), cB + kstep, voffB); PG8_STAGE(PG8_SA(1, 0), cA + kstep, voffA); PG8_STAGE(PG8_SB(1, 1), cB + hstepB + kstep, voffB);
        PG8_WAIT_V(6); PG8_BAR;
    } else {
        PG8_STAGE(PG8_SB(0, 0), cB, voffB); PG8_STAGE(PG8_SA(0, 0), cA, voffA); PG8_STAGE(PG8_SB(0, 1), cB + hstepB, voffB); PG8_STAGE(PG8_SA(0, 1), cA + hstepA, voffA);
        if (wr == 1) PG8_BAR;
        PG8_WAIT_V(4); PG8_BAR;
        PG8_STAGE(PG8_SB(1, 0), cB + kstep, voffB); PG8_STAGE(PG8_SA(1, 0), cA + kstep, voffA); PG8_STAGE(PG8_SB(1, 1), cB + hstepB + kstep, voffB);
        PG8_WAIT_V(6); PG8_BAR;
    }
    for (;;) {
        const bool has_next = S.next(ui + 1, nxt);
        const char* nA = has_next ? (const char*)g.A + (size_t)nxt.pm * tstepA : cA; const char* nB = has_next ? (const char*)g.Bt + (size_t)nxt.pn * tstepB : cB;
        for (int t = 0; t < nt; t += 2) {
            const bool last = (t == nt - 2);
            const char* a1 = cA + (size_t)(t + 1) * kstep;
            const char* a2 = last ? nA : cA + (size_t)(t + 2) * kstep; const char* b2 = last ? nB : cB + (size_t)(t + 2) * kstep;
            const char* a3 = a2 + kstep; const char* b3 = b2 + kstep;
            if (last && has_next) S.a_ready(nxt);
            if constexpr (SP2) {
            PG8_LDB(B0, 0, 0); PG8_LDB(B1, 0, 1); PG8_SCHED; PG8_LDA(At, 0, 0); PG8_STAGE(PG8_SA(1, 1), a1 + hstepA, voffA);
            PG8_WAIT_V(8); PG8_WAIT_L(0); PG8_BAR; PG8_MMA(0, 0, At, B0); PG8_MMA(0, 1, At, B1); PG8_BAR; PG8_SCHED;
            PG8_LDA(At, 0, 1); PG8_STAGE(PG8_SB(0, 0), b2, voffB); PG8_STAGE(PG8_SB(0, 1), b2 + hstepB, voffB); PG8_STAGE(PG8_SA(0, 0), a2, voffA);
            PG8_WAIT_V(8); PG8_WAIT_L(0); PG8_BAR; PG8_MMA(1, 0, At, B0); PG8_MMA(1, 1, At, B1); PG8_BAR; PG8_SCHED;
            PG8_LDB(B0, 1, 0); PG8_LDB(B1, 1, 1); PG8_SCHED; PG8_LDA(At, 1, 0); PG8_STAGE(PG8_SA(0, 1), a2 + hstepA, voffA);
            PG8_WAIT_V(8); PG8_WAIT_L(0); PG8_BAR; PG8_MMA(0, 0, At, B0); PG8_MMA(0, 1, At, B1); PG8_BAR; PG8_SCHED;
            PG8_LDA(At, 1, 1); PG8_STAGE(PG8_SB(1, 0), b3, voffB); PG8_STAGE(PG8_SB(1, 1), b3 + hstepB, voffB); PG8_STAGE(PG8_SA(1, 0), a3, voffA);
            PG8_WAIT_V(8); PG8_WAIT_L(0); PG8_BAR; PG8_MMA(1, 0, At, B0); PG8_MMA(1, 1, At, B1); PG8_BAR; PG8_SCHED;
            } else {
            PG8_LDB(B0, 0, 0); PG8_SCHED; PG8_LDA(At, 0, 0); PG8_STAGE(PG8_SA(1, 1), a1 + hstepA, voffA);
            PG8_WAIT_L(8); PG8_BAR; PG8_WAIT_L(0); PG8_MMA(0, 0, At, B0); PG8_BAR; PG8_SCHED;
            PG8_LDB(B1, 0, 1); PG8_STAGE(PG8_SB(0, 0), b2, voffB);
            PG8_BAR; PG8_WAIT_L(0); PG8_MMA(0, 1, At, B1); PG8_BAR;
            PG8_LDA(At, 0, 1); PG8_STAGE(PG8_SA(0, 0), a2, voffA);
            PG8_BAR; PG8_WAIT_L(0); PG8_MMA(1, 0, At, B0); PG8_BAR; PG8_SCHED;
            PG8_STAGE(PG8_SB(0, 1), b2 + hstepB, voffB);
            PG8_WAIT_V(6); PG8_BAR; PG8_MMA(1, 1, At, B1); PG8_BAR;
            PG8_LDB(B0, 1, 0); PG8_SCHED; PG8_LDA(At, 1, 0); PG8_STAGE(PG8_SA(0, 1), a2 + hstepA, voffA);
            PG8_WAIT_L(8); PG8_BAR; PG8_WAIT_L(0); PG8_MMA(0, 0, At, B0); PG8_BAR; PG8_SCHED;
            PG8_LDB(B1, 1, 1); PG8_STAGE(PG8_SB(1, 0), b3, voffB);
            PG8_BAR; PG8_WAIT_L(0); PG8_MMA(0, 1, At, B1); PG8_BAR;
            PG8_LDA(At, 1, 1); PG8_STAGE(PG8_SA(1, 0), a3, voffA);
            PG8_BAR; PG8_WAIT_L(0); PG8_MMA(1, 0, At, B0); PG8_BAR; PG8_SCHED;
            PG8_STAGE(PG8_SB(1, 1), b3 + hstepB, voffB);
            PG8_WAIT_V(6); PG8_BAR; PG8_MMA(1, 1, At, B1); PG8_BAR;
            }
        }
        if constexpr (ALIGN_EPI) { if (wr == 0) PG8_BAR; }
        if constexpr (!Epi::AFTER_DRAIN) { E(acc, cur, wr, wc, fr, fq); S.done(cur); }
        if (!has_next) break;
#pragma unroll
        for (int a = 0; a < 2; ++a)
#pragma unroll
            for (int b = 0; b < 2; ++b)
#pragma unroll
                for (int m = 0; m < 4; ++m)
#pragma unroll
                    for (int n = 0; n < 2; ++n) acc[a][b][m][n] = (f32x4){0.f, 0.f, 0.f, 0.f};
        cur = nxt; cA = nA; cB = nB; ++ui;
        if constexpr (ALIGN_EPI) { if (wr == 1) PG8_BAR; }
    }
    PG8_WAIT_V(0);
    if constexpr (!ALIGN_EPI) { if (wr == 0) PG8_BAR; }
    PG8_BAR;
    if constexpr (Epi::AFTER_DRAIN) { E.fused(acc, cur, wr, wc, fr, fq, lds, wid, lane); S.done(cur); }
#undef PG8_SA
#undef PG8_SB
#undef PG8_STAGE
#undef PG8_LDA
#undef PG8_LDB
#undef PG8_MMA
#undef PG8_WAIT_V
#undef PG8_WAIT_L
#undef PG8_BAR
#undef PG8_SCHED
}
}


#define GAS __attribute__((address_space(1)))
#define LAS __attribute__((address_space(3)))
typedef GAS unsigned gu32;
#define RLX_AGENT __ATOMIC_RELAXED, __HIP_MEMORY_SCOPE_AGENT
constexpr int RING_BYTES = 131072;
constexpr int LDSCTL_OFF = RING_BYTES, MISC_OFF = LDSCTL_OFF + 320;
constexpr int LDS_BYTES = 147456;
#ifndef CUT_MASK
#define CUT_MASK 0x00
#endif
constexpr int N_PHASES = 8;

#define XB_TMO      128
#define XB_XCNT(j)  (256  + 64 * (j))
#define XB_XSUB(j)  (1280 + 64 * (j))
#define XB_XGEN(j)  (2304 + 64 * (j))
#define XB_TOP      3328
#define XB_TOPGEN   3392
#define XCD_BAR_WORDS 3456
#define XB_SPIN_CAP (1u << 22)

__device__ __forceinline__ unsigned xb_ld(unsigned* p)              { return __hip_atomic_load(p, __ATOMIC_RELAXED, __HIP_MEMORY_SCOPE_AGENT); }
__device__ __forceinline__ unsigned xb_add(unsigned* p, unsigned v) { return __hip_atomic_fetch_add(p, v, __ATOMIC_RELAXED, __HIP_MEMORY_SCOPE_AGENT); }
__device__ __forceinline__ unsigned xb_xcc_id() { return (unsigned)__builtin_amdgcn_s_getreg((3 << 11) | 20) & 0xFu; }
#define XB_SPIN(cond, bar) do { unsigned _sp = 0; while (cond) { __builtin_amdgcn_s_sleep(1); \
    if ((++_sp & 255u) == 0u) { if (xb_ld(&(bar)[XB_TMO])) break; if (_sp > XB_SPIN_CAP) { atomicAdd(&(bar)[XB_TMO], 1u); break; } } } } while (0)

struct XcdBarrier {
    unsigned* bar; unsigned x;
    volatile LAS unsigned* st;
};

__device__ __forceinline__ XcdBarrier xcd_barrier_post(unsigned* bar, volatile LAS unsigned* st) {
    XcdBarrier b; b.bar = bar; b.x = xb_xcc_id(); b.st = st;
    if (threadIdx.x == 0) (void)xb_add(&bar[XB_XCNT(b.x)], 1u);
    return b;
}
__device__ __forceinline__ void xcd_barrier_complete(unsigned* bar, unsigned x, unsigned& nloc, unsigned& nx) {
    const unsigned G = gridDim.x * gridDim.y * gridDim.z;
    unsigned sum, cnt, mine, sp = 0u;
    for (;;) {
        sum = 0u; cnt = 0u; mine = 0u;
#pragma unroll
        for (unsigned j = 0; j < 16; ++j) { const unsigned c = xb_ld(&bar[XB_XCNT(j)]); sum += c; cnt += (c > 0u) ? 1u : 0u; mine = (j == x) ? c : mine; }
        if (sum == G) break;
        __builtin_amdgcn_s_sleep(1);
        if ((++sp & 255u) == 0u) { if (xb_ld(&bar[XB_TMO])) break; if (sp > XB_SPIN_CAP) { atomicAdd(&bar[XB_TMO], 1u); break; } }
    }
    nloc = mine > 0u ? mine : 1u; nx = cnt > 0u ? cnt : 1u;
}

__device__ __forceinline__ void xcd_barrier(const XcdBarrier& b) {
    asm volatile("s_waitcnt vmcnt(0)" ::: "memory");
    __syncthreads();
    if (threadIdx.x == 0) {
        unsigned* bar = b.bar;
        __builtin_amdgcn_s_waitcnt(0);
        unsigned nloc = b.st[0], nx = b.st[1];
        if (nloc == 0u) { xcd_barrier_complete(bar, b.x, nloc, nx); b.st[0] = nloc; b.st[1] = nx; }
        const unsigned old = xb_add(&bar[XB_XSUB(b.x)], 1u);
        const unsigned gen = old / nloc;
        if (old + 1u == (gen + 1u) * nloc) {
            __builtin_amdgcn_fence(__ATOMIC_RELEASE, "agent");
            asm volatile("s_waitcnt vmcnt(0)" ::: "memory");
            const unsigned og = xb_add(&bar[XB_TOP], 1u);
            const unsigned tg = og / nx;
            if (og + 1u == (tg + 1u) * nx) xb_add(&bar[XB_TOPGEN], 1u);
            else XB_SPIN(xb_ld(&bar[XB_TOPGEN]) == tg, bar);
            __builtin_amdgcn_fence(__ATOMIC_ACQUIRE, "agent");
            xb_add(&bar[XB_XGEN(b.x)], 1u);
            asm volatile("s_waitcnt vmcnt(0)" ::: "memory");
        } else {
            XB_SPIN(xb_ld(&bar[XB_XGEN(b.x)]) == gen, bar);
            __builtin_amdgcn_fence(__ATOMIC_ACQUIRE, "agent");
            asm volatile("s_waitcnt vmcnt(0)" ::: "memory");
        }
    }
    __syncthreads();
}


enum { TM_IN = 0, TM_UQ = 1, TM_UKV = 2, TM_OUT = 3 };
__device__ __forceinline__ int dst_row(int mode, int n) {
    if (mode == TM_IN) {
        if (n < 4096) return n;
        if (n < 4112) return NPROJ + (n - 4096);
        if (n < 6160) return PC_GGATE + (n - 4112);
        if (n < 7696) return PC_MCQ + (n - 6160);
        if (n < 8208) return PC_MCKV + (n - 7696);
        if (n < 8272) { const int p = n - 8208; return NPROJ + 16 + 2 * (p & 31) + (p >> 5); }
        return PC_MGATE + (n - 8272);
    } else if (mode == TM_UQ) {
        const int h = n / 192, d = n % 192;
        if (d < 128) return h * 128 + d;
        const int p = d - 128; return 2048 + h * 64 + 2 * (p & 31) + (p >> 5);
    } else if (mode == TM_UKV) {
        const int h = n / 256, d = n % 256;
        return d < 128 ? h * 128 + d : 2048 + h * 128 + (d - 128);
    } else return n;
}
struct TrMat { const float* W; bf16_t* WT; int K, N, mode, nblk, rsoff; };
__device__ __forceinline__ unsigned cvtpk_rne(float lo, float hi) { unsigned r; asm volatile("v_cvt_pk_bf16_f32 %0, %1, %2" : "=v"(r) : "v"(lo), "v"(hi)); return r; }
constexpr int TR_P = 257, TR_T = 32 * TR_P;
__device__ __forceinline__ void tr_tile_load(const TrMat& t, int tile, int wave, int lane, f32x4 (&v)[8]) {
    const int kb = tile / t.nblk, nb = tile - kb * t.nblk, k0 = 64 * kb, n0 = 256 * nb;
    const bool ok = n0 + 4 * lane < t.N;
    const float* p = t.W + (size_t)(k0 + 8 * wave) * t.N + n0 + 4 * lane;
#pragma unroll
    for (int i = 0; i < 8; ++i) v[i] = ok ? __builtin_nontemporal_load((const f32x4*)(p + (size_t)i * t.N)) : (f32x4){0.f, 0.f, 0.f, 0.f};
}
__device__ __forceinline__ void tr_tile_pack(const TrMat& t, int tile, int wave, int lane, const f32x4 (&v)[8], unsigned* T, const float* rsl) {
    const int kb = tile / t.nblk, nb = tile - kb * t.nblk, k0 = 64 * kb, n0 = 256 * nb;
    const float cs = (t.mode == TM_IN && n0 < 1024) ? 0.125f : 1.f;
    unsigned* d = T + (4 * wave) * TR_P + 4 * lane;
#pragma unroll
    for (int pr = 0; pr < 4; ++pr) { const float s0 = (t.rsoff >= 0 ? rsl[t.rsoff + k0 + 8 * wave + 2 * pr] : 1.f) * cs, s1 = (t.rsoff >= 0 ? rsl[t.rsoff + k0 + 8 * wave + 2 * pr + 1] : 1.f) * cs;
#pragma unroll
        for (int c = 0; c < 4; ++c) d[pr * TR_P + c] = cvtpk_rne(v[2 * pr][c] * s0, v[2 * pr + 1][c] * s1); }
}
__device__ __forceinline__ void tr_tile_store(const TrMat& t, int tile, int wave, int lane, const unsigned* T) {
    const int kb = tile / t.nblk, nb = tile - kb * t.nblk, k0 = 64 * kb, n0 = 256 * nb, q = lane & 7;
#pragma unroll
    for (int j = 0; j < 4; ++j) { const int n = 32 * wave + 8 * j + (lane >> 3); const unsigned* s = T + (4 * q) * TR_P + n;
        if (n0 + n < t.N) { u32x4 o; o.x = s[0]; o.y = s[TR_P]; o.z = s[2 * TR_P]; o.w = s[3 * TR_P];
            *(u32x4*)(t.WT + (size_t)dst_row(t.mode, n0 + n) * t.K + k0 + 8 * q) = o; } }
}
__device__ __forceinline__ float mod_at(const float* __restrict__ MODP, const float* __restrict__ b_ada, int j) {
    float v = b_ada[j];
#pragma unroll
    for (int s = 0; s < 16; ++s) v += MODP[(size_t)s * 12288 + j];
    return v;
}
__device__ __forceinline__ f32x2 cos_sin_f32arg(float ang) {
    const double a = (double)ang;
    const double n = __builtin_rint(a * 0.63661977236758134308);
    double r = __builtin_fma(-n, 1.57079632679489655800e+00, a); r = __builtin_fma(-n, 6.12323399573676603587e-17, r);
    const double r2 = r * r;
    const double sn = r + r * r2 * (-1.0 / 6 + r2 * (1.0 / 120 + r2 * (-1.0 / 5040 + r2 * (1.0 / 362880 + r2 * (-1.0 / 39916800)))));
    const double cs = 1.0 + r2 * (-0.5 + r2 * (1.0 / 24 + r2 * (-1.0 / 720 + r2 * (1.0 / 40320 + r2 * (-1.0 / 3628800 + r2 * (1.0 / 479001600))))));
    const int q = ((int)(long long)n) & 3;
    double co, si;
    if (q == 0) { co = cs; si = sn; } else if (q == 1) { co = -sn; si = cs; } else if (q == 2) { co = -cs; si = -sn; } else { co = sn; si = -cs; }
    return (f32x2){(float)co, (float)si};
}
struct P0Args { const float *w_in, *w_uq, *w_ukv, *w_out, *g_qn, *g_kvn, *c, *w_ada; const int* pos; bf16_t *WTALL, *WTUQ, *WTUKV, *WTOUT; float* MODP; f32x2* ROPE; };
__device__ __forceinline__ void p0_prologue(const P0Args& a, float* ldsf, int vcu, int G) {
    const int tid = threadIdx.x, wave = tid >> 6, lane = tid & 63;
    float* scr = ldsf + wave * (64 * 33); float* sc = ldsf + 8 * 64 * 33;
    for (int i = tid; i < DM; i += NT) sc[i] = silu_f(a.c[i]);
    __syncthreads();
    const int gw = vcu * NWAVES + wave, NGW = G * NWAVES;
    if (G == 256) {
        const int s = vcu >> 4, cset = vcu & 15, kb = s * 256 + wave * 32;
        const float* wp = a.w_ada + (size_t)kb * 12288 + cset * 768 + 4 * lane;
        f32x4 acc0 = {0.f, 0.f, 0.f, 0.f}, acc1 = acc0, acc2 = acc0;
#pragma unroll 8
        for (int k = 0; k < 32; ++k) { const float av = sc[kb + k]; const f32x4* rp = (const f32x4*)(wp + (size_t)k * 12288);
            const f32x4 w0 = __builtin_nontemporal_load(rp), w1 = __builtin_nontemporal_load(rp + 64), w2 = __builtin_nontemporal_load(rp + 128);
            acc0 += av * w0; acc1 += av * w1; acc2 += av * w2; }
        float* red = ldsf + wave * 768 + 4 * lane;
        *(f32x4*)red = acc0; *(f32x4*)(red + 256) = acc1; *(f32x4*)(red + 512) = acc2;
        __syncthreads();
        for (int e = tid; e < 768; e += NT) { float t = 0.f;
#pragma unroll
            for (int w = 0; w < 8; ++w) t += ldsf[w * 768 + e];
            a.MODP[(size_t)s * 12288 + cset * 768 + e] = t; }
        __syncthreads();
    } else
    for (int task = gw; task < 96 * 16; task += NGW) {
        const int g = task % 96, s = task / 96, k0 = s * 256;
        const float* wp = a.w_ada + (size_t)k0 * 12288 + g * 128 + 2 * lane;
        f32x2 acc = {0.f, 0.f};
#pragma unroll 16
        for (int k = 0; k < 256; ++k) { const f32x2 w = __builtin_nontemporal_load((const f32x2*)(wp + (size_t)k * 12288)); const float av = sc[k0 + k]; acc.x += av * w.x; acc.y += av * w.y; }
        *(f32x2*)(a.MODP + (size_t)s * 12288 + g * 128 + 2 * lane) = acc;
    }
    constexpr int T_IN = (DM / 64) * ((IN_WIDTH + 255) / 256), T_UQ = (QRANK / 64) * (NQ / 256), T_UKV = (KVRANK / 64) * (NKV / 256), T_OUT = (DM / 64) * (DM / 256), T_ALL = T_IN + T_UQ + T_UKV + T_OUT;
    const TrMat mIN{a.w_in, a.WTALL, DM, IN_WIDTH, TM_IN, (IN_WIDTH + 255) / 256, -1}, mUQ{a.w_uq, a.WTUQ, QRANK, NQ, TM_UQ, NQ / 256, 0},
                mUKV{a.w_ukv, a.WTUKV, KVRANK, NKV, TM_UKV, NKV / 256, QRANK}, mOUT{a.w_out, a.WTOUT, DM, DM, TM_OUT, DM / 256, -1};
#define TR_PICK(it_, M_, r_) do { r_ = (it_); if (r_ < T_IN) M_ = mIN; else { r_ -= T_IN; if (r_ < T_UQ) M_ = mUQ; else { r_ -= T_UQ; if (r_ < T_UKV) M_ = mUKV; else { r_ -= T_UKV; M_ = mOUT; } } } } while (0)
    __syncthreads();
    for (int i = tid; i < QRANK + KVRANK; i += NT) sc[i] = i < QRANK ? a.g_qn[i] : a.g_kvn[i - QRANK];
    __syncthreads();
    { unsigned* T = (unsigned*)ldsf; f32x4 v[8]; TrMat M = mIN; int r = 0, buf = 0;
      int t = vcu;
      if (t < T_ALL) { TR_PICK(t, M, r); tr_tile_load(M, r, wave, lane, v); }
      for (; t < T_ALL; t += G, buf ^= 1) {
          tr_tile_pack(M, r, wave, lane, v, T + buf * TR_T, sc);
          const TrMat Mc = M; const int rc = r;
          if (t + G < T_ALL) { TR_PICK(t + G, M, r); tr_tile_load(M, r, wave, lane, v); }
          __syncthreads();
          tr_tile_store(Mc, rc, wave, lane, T + buf * TR_T);
      }
      __syncthreads(); }
#undef TR_PICK
    for (int idx = vcu * NT + tid; idx < S * 32; idx += G * NT) {
        const int s = idx >> 5, i = idx & 31;
        const float inv_freq = powf(10000.0f, -(float)i / 32.0f);
        a.ROPE[idx] = cos_sin_f32arg((float)a.pos[s] * inv_freq);
    }
}
__device__ __forceinline__ void p1_hnorm(const float* __restrict__ x, const float* __restrict__ g_pre, const float* __restrict__ MODP, const float* __restrict__ b_ada, bf16_t* __restrict__ H, float* ldsf, int vcu, int G) {
    float* tA = ldsf; float* tB = ldsf + DM;
    { float sh[8], sc[8];
#pragma unroll
      for (int j = 0; j < 8; ++j) { sh[j] = b_ada[threadIdx.x + NT * j]; sc[j] = b_ada[DM + threadIdx.x + NT * j]; }
#pragma unroll 4
      for (int s = 0; s < 16; ++s) { const float* mp = MODP + (size_t)s * 12288 + threadIdx.x;
#pragma unroll
          for (int j = 0; j < 8; ++j) { sh[j] += mp[NT * j]; sc[j] += mp[DM + NT * j]; } }
#pragma unroll
      for (int j = 0; j < 8; ++j) { const int c = threadIdx.x + NT * j; tA[c] = g_pre[c] * (1.f + sc[j]); tB[c] = sh[j]; } }
    __syncthreads();
    const int wave = threadIdx.x >> 6, lane = threadIdx.x & 63;
    for (int m = vcu * NWAVES + wave; m < S; m += G * NWAVES) {
        const f32x4* xr = (const f32x4*)(x + (size_t)m * DM) + lane;
        f32x4 v[16]; float ss = 0.f;
#pragma unroll
        for (int j = 0; j < 16; ++j) { v[j] = __builtin_nontemporal_load(xr + 64 * j); ss += (v[j].x * v[j].x + v[j].y * v[j].y) + (v[j].z * v[j].z + v[j].w * v[j].w); }
        const float rstd = 1.0f / sqrtf(wave_sum(ss) * (1.f / DM) + EPS);
        u32x2* o = (u32x2*)(H + (size_t)m * DM) + lane;
#pragma unroll
        for (int j = 0; j < 16; ++j) { const int c = 256 * j + 4 * lane;
            const f32x4 av = *(const f32x4*)(tA + c), bv = *(const f32x4*)(tB + c);
            u32x2 w; w.x = pk2(v[j].x * rstd * av.x + bv.x, v[j].y * rstd * av.y + bv.y); w.y = pk2(v[j].z * rstd * av.z + bv.z, v[j].w * rstd * av.w + bv.w);
            o[64 * j] = w; }
    }
    __syncthreads();
}
constexpr int TB_PITCH = 544;
constexpr size_t THINP_STRIDE = (size_t)S * NTHIN;
__device__ __forceinline__ void thin_gemm(const bf16_t* __restrict__ H, const bf16_t* __restrict__ WTHIN, float* __restrict__ THINP, float* ldsf, int vcu, int G) {
    const int tid = threadIdx.x, wave = tid >> 6, lane = tid & 63, fr = lane & 15, fq = lane >> 4;
    char* lb = (char*)ldsf;
    const int srow = tid >> 5, sc16 = tid & 31;
    for (int it = vcu; it < 256; it += G) {
        const int rbk = it >> 2, kq = it & 3;
        const bf16_t* ap = H + (size_t)(rbk * 128 + wave * 16 + fr) * DM + kq * 1024 + 8 * fq;
        const bf16_t* bg = WTHIN + (size_t)srow * DM + kq * 1024 + sc16 * 8;
        f32x4 acc[5];
#pragma unroll
        for (int j = 0; j < 5; ++j) acc[j] = (f32x4){0.f, 0.f, 0.f, 0.f};
        bf16x8 st[5], av[8];
#pragma unroll
        for (int i = 0; i < 5; ++i) st[i] = *(const bf16x8*)(bg + (size_t)(16 * i) * DM);
#pragma unroll
        for (int ks = 0; ks < 8; ++ks) av[ks] = *(const bf16x8*)(ap + ks * 32);
#pragma unroll
        for (int i = 0; i < 5; ++i) *(bf16x8*)(lb + (srow + 16 * i) * TB_PITCH + sc16 * 16) = st[i];
        __syncthreads();
#pragma unroll
        for (int c = 0; c < 4; ++c) {
            const char* cur = lb + (c & 1) * (80 * TB_PITCH) + fr * TB_PITCH + fq * 16;
            bf16x8 an[8];
            if (c + 1 < 4) {
#pragma unroll
                for (int i = 0; i < 5; ++i) st[i] = *(const bf16x8*)(bg + (size_t)(16 * i) * DM + (c + 1) * 256);
#pragma unroll
                for (int ks = 0; ks < 8; ++ks) an[ks] = *(const bf16x8*)(ap + (c + 1) * 256 + ks * 32);
            }
            __builtin_amdgcn_sched_barrier(0);
#pragma unroll
            for (int ks = 0; ks < 8; ++ks)
#pragma unroll
                for (int j = 0; j < 5; ++j) { const bf16x8 bv = *(const bf16x8*)(cur + (16 * j) * TB_PITCH + ks * 64); acc[j] = __builtin_amdgcn_mfma_f32_16x16x32_bf16(bv, av[ks], acc[j], 0, 0, 0); }
            __builtin_amdgcn_sched_barrier(0);
            if (c + 1 < 4) {
#pragma unroll
                for (int i = 0; i < 5; ++i) *(bf16x8*)(lb + ((c + 1) & 1) * (80 * TB_PITCH) + (srow + 16 * i) * TB_PITCH + sc16 * 16) = st[i];
#pragma unroll
                for (int ks = 0; ks < 8; ++ks) av[ks] = an[ks];
            }
            __syncthreads();
        }
        float* op = THINP + (size_t)kq * THINP_STRIDE + (size_t)(rbk * 128 + wave * 16 + fr) * NTHIN + 4 * fq;
#pragma unroll
        for (int j = 0; j < 5; ++j) *(f32x4*)(op + 16 * j) = acc[j];
    }
}
__device__ __forceinline__ void p3_krope(const float* __restrict__ THIN, const f32x2* __restrict__ ROPE, bf16_t* __restrict__ KR, int vcu, int G) {
    for (int idx = vcu * NT + threadIdx.x; idx < S * 32; idx += G * NT) { const int m = idx >> 5, i = idx & 31;
        const float* tp = THIN + (size_t)m * NTHIN + 16 + 2 * i;
        const f32x2 xx = (*(const f32x2*)tp + *(const f32x2*)(tp + THINP_STRIDE)) + (*(const f32x2*)(tp + 2 * THINP_STRIDE) + *(const f32x2*)(tp + 3 * THINP_STRIDE)); const f32x2 cs = ROPE[idx];
        *(unsigned*)(KR + (size_t)m * 64 + 2 * i) = pk2(xx.x * cs.x - xx.y * cs.y, xx.y * cs.x + xx.x * cs.y); }
}
__device__ __forceinline__ void p7_final(const float* __restrict__ x, const bf16_t* __restrict__ MIXB, const float* __restrict__ SSQMIX, const float* __restrict__ g_post, const float* __restrict__ MODP, const float* __restrict__ b_ada, float* __restrict__ out, float* ldsf, int vcu, int G) {
    float* tG = ldsf;
    { float gt[8];
#pragma unroll
      for (int j = 0; j < 8; ++j) gt[j] = b_ada[2 * DM + threadIdx.x + NT * j];
#pragma unroll 8
      for (int s = 0; s < 16; ++s) { const float* mp = MODP + (size_t)s * 12288 + 2 * DM + threadIdx.x;
#pragma unroll
          for (int j = 0; j < 8; ++j) gt[j] += mp[NT * j]; }
#pragma unroll
      for (int j = 0; j < 8; ++j) { const int c = threadIdx.x + NT * j; tG[c] = gt[j] * g_post[c]; } }
    __syncthreads();
    const int wave = threadIdx.x >> 6, lane = threadIdx.x & 63;
    for (int m = vcu * NWAVES + wave; m < S; m += G * NWAVES) {
        const float rstd = 1.0f / sqrtf(wave_sum(SSQMIX[(size_t)m * 64 + lane]) * (1.f / DM) + EPS);
        const u32x2* mr = (const u32x2*)(MIXB + (size_t)m * DM) + lane; const f32x4* xr = (const f32x4*)(x + (size_t)m * DM) + lane;
        f32x4* o = (f32x4*)(out + (size_t)m * DM) + lane;
#pragma unroll
        for (int jj = 0; jj < 16; jj += 8) { f32x4 xv[8]; u32x2 mv[8];
#pragma unroll
            for (int j = 0; j < 8; ++j) { xv[j] = __builtin_nontemporal_load(xr + 64 * (jj + j)); mv[j] = __builtin_nontemporal_load(mr + 64 * (jj + j)); }
#pragma unroll
            for (int j = 0; j < 8; ++j) { const f32x4 g = *(const f32x4*)(tG + 256 * (jj + j) + 4 * lane);
                const f32x4 mf = {__uint_as_float(mv[j].x << 16), __uint_as_float(mv[j].x & 0xffff0000u), __uint_as_float(mv[j].y << 16), __uint_as_float(mv[j].y & 0xffff0000u)};
                __builtin_nontemporal_store(xv[j] + g * (mf * rstd), o + 64 * (jj + j)); } }
    }
}


namespace att {
typedef short s16x4 __attribute__((ext_vector_type(4)));
typedef float f32x16 __attribute__((ext_vector_type(16)));
constexpr int NW = 8, QBLK = 32, KVBLK = 64, QB = NW * QBLK;
constexpr int SHM_V = KVBLK * 128 * 2, SHM_K = KVBLK * 384;
constexpr int LDS_K = 2 * SHM_V, LDS_WS = 2 * SHM_V + 2 * SHM_K, LDS_QR = LDS_WS + NW * 64 * 4, LDS_BYTES = LDS_QR + NW * 4096;
constexpr float THR = 6.f;
#define ATT_KOFF(row, c) ((row) * 384 + ((((c) & ~7) | (((c) & 7) ^ (((row) >> 1) & 7))) << 4))
#define SBAR() __builtin_amdgcn_sched_barrier(0)
__device__ __forceinline__ int v_st(int k, int c) { const int kk = (k & ~0xC) | ((k & 4) << 1) | ((k & 8) >> 1); return ((kk >> 3) * 4 + (c >> 5)) * 512 + ((kk & 7) * 32 + (c & 31)) * 2; }
__device__ __forceinline__ int v_rd_base(int lane) { return ((lane & 3) << 3) | (((lane >> 2) & 3) << 6) | (((lane >> 4) & 1) << 5) | (((lane >> 5) & 1) << 8); }
constexpr int v_rd_off(int d0, int ks, int half) { return d0 * 512 + ks * 4096 + half * 2048; }
__device__ __forceinline__ int crow(int r, int hi) { return (r & 3) + 8 * (r >> 2) + 4 * hi; }
typedef float f32x2_t __attribute__((ext_vector_type(2))); typedef __bf16 bf16x2_t __attribute__((ext_vector_type(2)));
__device__ __forceinline__ unsigned cvtpk(float lo, float hi) { f32x2_t v = {lo, hi}; bf16x2_t b = __builtin_convertvector(v, bf16x2_t); return __builtin_bit_cast(unsigned, b); }

__device__ __forceinline__ void partialSM(f32x16& p0, f32x16& p1, float& m_reg, float& alpha, bool act) {
    float pmax = p0[0];
#pragma unroll
    for (int r = 1; r < 16; ++r) pmax = fmaxf(pmax, p0[r]);
#pragma unroll
    for (int r = 0; r < 16; ++r) pmax = fmaxf(pmax, p1[r]);
    { auto rr = __builtin_amdgcn_permlane32_swap(__float_as_uint(pmax), __float_as_uint(pmax), false, false);
      pmax = fmaxf(__uint_as_float(rr[0]), __uint_as_float(rr[1])); }
    if (!act) pmax = -__builtin_inff();
    float mn;
    if (__builtin_expect(__all((pmax - m_reg) <= THR), 1)) { mn = m_reg; alpha = 1.f; }
    else { mn = fmaxf(m_reg, pmax); alpha = __builtin_amdgcn_exp2f(m_reg - mn); m_reg = mn; }
    if (!act) mn = __builtin_inff();
#pragma unroll
    for (int r = 0; r < 16; ++r) p0[r] = p0[r] - mn;
#pragma unroll
    for (int r = 0; r < 16; ++r) p1[r] = p1[r] - mn;
#pragma unroll
    for (int r = 0; r < 16; ++r) p0[r] = __builtin_amdgcn_exp2f(p0[r]);
}
__device__ __forceinline__ void finishSM(f32x16& p0, f32x16& p1, float alpha, float& l_reg, bf16x8& pa0, bf16x8& pa1, bf16x8& pa2, bf16x8& pa3) {
#pragma unroll
    for (int r = 0; r < 16; ++r) p1[r] = __builtin_amdgcn_exp2f(p1[r]);
    float ps = 0;
#pragma unroll
    for (int r = 0; r < 16; ++r) ps += p0[r];
#pragma unroll
    for (int r = 0; r < 16; ++r) ps += p1[r];
    { auto rr = __builtin_amdgcn_permlane32_swap(__float_as_uint(ps), __float_as_uint(ps), false, false);
      ps = __uint_as_float(rr[0]) + __uint_as_float(rr[1]); }
    l_reg = l_reg * alpha + ps;
#define PK4(P, B_, OUT) do { unsigned a0 = cvtpk(P[B_+0], P[B_+1]), a1 = cvtpk(P[B_+2], P[B_+3]);                          \
        unsigned b0 = cvtpk(P[B_+4], P[B_+5]), b1 = cvtpk(P[B_+6], P[B_+7]);                                             \
        auto r0 = __builtin_amdgcn_permlane32_swap(a0, b0, false, false); auto r1 = __builtin_amdgcn_permlane32_swap(a1, b1, false, false); \
        u32x4 w = {r0[0], r1[0], r0[1], r1[1]}; OUT = *reinterpret_cast<bf16x8*>(&w); } while (0)
    PK4(p0, 0, pa0); PK4(p0, 8, pa1); PK4(p1, 0, pa2); PK4(p1, 8, pa3);
#undef PK4
}
template <int KB>
__device__ __forceinline__ void qkt(f32x16& p0, f32x16& p1, const char* K_lds, int r32, int hi, const bf16x8* qr, const char* qlds) {
    p0 = f32x16{}; p1 = f32x16{};
    const char* kb[4];
#pragma unroll
    for (int dd = 0; dd < 4; ++dd) kb[dd] = K_lds + KB * SHM_K + ATT_KOFF(r32, 2 * dd + hi);
#pragma unroll
    for (int d0 = 0; d0 < 12; ++d0) { const char* a = kb[d0 & 3] + (d0 >> 2) * 128;
        bf16x8 b0 = *reinterpret_cast<const bf16x8*>(a);
        bf16x8 b1 = *reinterpret_cast<const bf16x8*>(a + 32 * 384);
        const bf16x8 qf = d0 < 8 ? qr[d0] : *reinterpret_cast<const bf16x8*>(qlds + (d0 - 8) * 1024);
        p0 = __builtin_amdgcn_mfma_f32_32x32x16_bf16(b0, qf, p0, 0, 0, 0);
        p1 = __builtin_amdgcn_mfma_f32_32x32x16_bf16(b1, qf, p1, 0, 0, 0); }
}
template <int KB>
__device__ __forceinline__ void qkt_fsm(f32x16& p0, f32x16& p1, const char* K_lds, int r32, int hi, const bf16x8* qr, const char* qlds,
                                        f32x16& y0, f32x16& y1, float alpha, float& l_reg, bf16x8& pa0, bf16x8& pa1, bf16x8& pa2, bf16x8& pa3) {
    p0 = f32x16{}; p1 = f32x16{};
    const char* kb[4];
#pragma unroll
    for (int dd = 0; dd < 4; ++dd) kb[dd] = K_lds + KB * SHM_K + ATT_KOFF(r32, 2 * dd + hi);
    bf16x8 b0 = *reinterpret_cast<const bf16x8*>(kb[0]), b1 = *reinterpret_cast<const bf16x8*>(kb[0] + 32 * 384);
    float ps = 0.f; unsigned ca0 = 0, ca1 = 0, cb0 = 0, cb1 = 0; u32x4 w0 = {}, w1 = {}, w2 = {}, w3 = {};
#define FS_SUM4(Y, B_) ps += (Y[B_] + Y[B_ + 1]) + (Y[B_ + 2] + Y[B_ + 3])
#define FS_EXP2(B_) do { y1[B_] = __builtin_amdgcn_exp2f(y1[B_]); y1[B_ + 1] = __builtin_amdgcn_exp2f(y1[B_ + 1]); } while (0)
#define FS_PKH0(Y, B_, W) do { ca0 = cvtpk(Y[B_ + 0], Y[B_ + 1]); cb0 = cvtpk(Y[B_ + 4], Y[B_ + 5]); auto r_ = __builtin_amdgcn_permlane32_swap(ca0, cb0, false, false); W[0] = r_[0]; W[2] = r_[1]; } while (0)
#define FS_PKH1(Y, B_, W) do { ca1 = cvtpk(Y[B_ + 2], Y[B_ + 3]); cb1 = cvtpk(Y[B_ + 6], Y[B_ + 7]); auto r_ = __builtin_amdgcn_permlane32_swap(ca1, cb1, false, false); W[1] = r_[0]; W[3] = r_[1]; } while (0)
#pragma unroll
    for (int d0 = 0; d0 < 12; ++d0) {
        bf16x8 n0 = b0, n1 = b1;
        if (d0 < 11) { const char* an = kb[(d0 + 1) & 3] + ((d0 + 1) >> 2) * 128; n0 = *reinterpret_cast<const bf16x8*>(an); n1 = *reinterpret_cast<const bf16x8*>(an + 32 * 384); }
        const bf16x8 qf = d0 < 8 ? qr[d0] : *reinterpret_cast<const bf16x8*>(qlds + (d0 - 8) * 1024);
        p0 = __builtin_amdgcn_mfma_f32_32x32x16_bf16(b0, qf, p0, 0, 0, 0);
        p1 = __builtin_amdgcn_mfma_f32_32x32x16_bf16(b1, qf, p1, 0, 0, 0);
        if (d0 == 0) { FS_SUM4(y0, 0); FS_PKH0(y0, 0, w0); FS_EXP2(0); }
        if (d0 == 1) { FS_SUM4(y0, 4); FS_PKH1(y0, 0, w0); FS_EXP2(2); }
        if (d0 == 2) { FS_SUM4(y0, 8); FS_PKH0(y0, 8, w1); FS_EXP2(4); }
        if (d0 == 3) { FS_SUM4(y0, 12); FS_PKH1(y0, 8, w1); FS_EXP2(6); }
        if (d0 == 4) { FS_EXP2(8); FS_SUM4(y1, 0); }
        if (d0 == 5) { FS_EXP2(10); FS_SUM4(y1, 4); }
        if (d0 == 6) { FS_EXP2(12); FS_PKH0(y1, 0, w2); }
        if (d0 == 7) { FS_EXP2(14); FS_PKH1(y1, 0, w2); }
        if (d0 == 8) { FS_SUM4(y1, 8); FS_PKH0(y1, 8, w3); }
        if (d0 == 9) { FS_SUM4(y1, 12); FS_PKH1(y1, 8, w3); }
        if (d0 == 10) { auto rr = __builtin_amdgcn_permlane32_swap(__float_as_uint(ps), __float_as_uint(ps), false, false); ps = __uint_as_float(rr[0]) + __uint_as_float(rr[1]); l_reg = l_reg * alpha + ps; }
        b0 = n0; b1 = n1;
        SBAR();
    }
    pa0 = __builtin_bit_cast(bf16x8, w0); pa1 = __builtin_bit_cast(bf16x8, w1); pa2 = __builtin_bit_cast(bf16x8, w2); pa3 = __builtin_bit_cast(bf16x8, w3);
#undef FS_SUM4
#undef FS_EXP2
#undef FS_PKH0
#undef FS_PKH1
}
template <int VB>
__device__ __forceinline__ void pv_tile(f32x16* o, int vb0, bf16x8 pa0, bf16x8 pa1, bf16x8 pa2, bf16x8 pa3) {
#define TRRD(dst, off) asm volatile("ds_read_b64_tr_b16 %0, %1 offset:%2" : "=&v"(dst) : "v"(vb0), "i"(off) : "memory")
#define PV_D0(d0) do { s16x4 l0, l1, l2, l3, h0, h1, h2, h3; constexpr int b_ = VB * SHM_V + v_rd_off(d0, 0, 0); \
        TRRD(l0, b_); TRRD(h0, b_ + 2048); TRRD(l1, b_ + 4096); TRRD(h1, b_ + 6144); TRRD(l2, b_ + 8192); TRRD(h2, b_ + 10240); TRRD(l3, b_ + 12288); TRRD(h3, b_ + 14336); \
        asm volatile("s_waitcnt lgkmcnt(0)" ::: "memory"); SBAR(); \
        o[d0] = __builtin_amdgcn_mfma_f32_32x32x16_bf16(pa0, (bf16x8){l0[0], l0[1], l0[2], l0[3], h0[0], h0[1], h0[2], h0[3]}, o[d0], 0, 0, 0);   \
        o[d0] = __builtin_amdgcn_mfma_f32_32x32x16_bf16(pa1, (bf16x8){l1[0], l1[1], l1[2], l1[3], h1[0], h1[1], h1[2], h1[3]}, o[d0], 0, 0, 0);   \
        o[d0] = __builtin_amdgcn_mfma_f32_32x32x16_bf16(pa2, (bf16x8){l2[0], l2[1], l2[2], l2[3], h2[0], h2[1], h2[2], h2[3]}, o[d0], 0, 0, 0);   \
        o[d0] = __builtin_amdgcn_mfma_f32_32x32x16_bf16(pa3, (bf16x8){l3[0], l3[1], l3[2], l3[3], h3[0], h3[1], h3[2], h3[3]}, o[d0], 0, 0, 0); } while (0)
    PV_D0(0); PV_D0(1); PV_D0(2); PV_D0(3);
#undef PV_D0
#undef TRRD
}
struct Tensors { const bf16_t* Q; const bf16_t* KV; const bf16_t* KR; const bf16_t* PROJ; bf16_t* MIXIN; };
struct Seam { bf16x8 qr[12]; bf16x8 st_v0, st_v1, st_k0, st_k1, st_kr; unsigned g_k, g_kr; int l_k0, l_kr, l_v0; };
#define ATT_VMW() asm volatile("s_waitcnt vmcnt(0)" ::: "memory")
#define ATT_VMWN(n) asm volatile("s_waitcnt vmcnt(%0)" :: "i"(n) : "memory")
#define ATT_OPQ(x) asm volatile("" : "+v"(x))
#define ATT_STG_INIT() do { int t_ = tid; ATT_OPQ(t_); const int sr_ = t_ >> 4, sc_ = (t_ & 15) * 8;                                   \
        S.g_k = (unsigned)(sr_ * NKV + sc_) * 2u; S.g_kr = (unsigned)((t_ >> 3) * 64 + (t_ & 7) * 8) * 2u;                            \
        S.l_k0 = ATT_KOFF(t_ >> 4, t_ & 15); S.l_kr = ATT_KOFF(t_ >> 3, 16 + (t_ & 7)); S.l_v0 = v_st(sr_, sc_);                        \
        ATT_OPQ(S.g_k); ATT_OPQ(S.g_kr); ATT_OPQ(S.l_k0); ATT_OPQ(S.l_kr); ATT_OPQ(S.l_v0); } while (0)
#define ATT_SLOAD(h_, k0) do { const char* kvb_ = (const char*)(T.KV + (size_t)(k0) * NKV + (h_) * 128); const char* krb_ = (const char*)(T.KR + (size_t)(k0) * 64);   \
        S.st_v0 = *(const bf16x8*)(kvb_ + 4096 + S.g_k); S.st_v1 = *(const bf16x8*)(kvb_ + (4096 + 32 * NKV * 2) + S.g_k);             \
        S.st_k0 = *(const bf16x8*)(kvb_ + S.g_k); S.st_k1 = *(const bf16x8*)(kvb_ + 32 * NKV * 2 + S.g_k);                              \
        S.st_kr = *(const bf16x8*)(krb_ + S.g_kr); } while (0)
#define ATT_SWRITE_K(bf) do { *(bf16x8*)(K_lds + (bf) * SHM_K + S.l_k0) = S.st_k0; *(bf16x8*)(K_lds + (bf) * SHM_K + S.l_k0 + 32 * 384) = S.st_k1; *(bf16x8*)(K_lds + (bf) * SHM_K + S.l_kr) = S.st_kr; } while (0)
#define ATT_SWRITE_V(bf) do { *(bf16x8*)(V_lds + (bf) * SHM_V + S.l_v0) = S.st_v0; *(bf16x8*)(V_lds + (bf) * SHM_V + S.l_v0 + 8192) = S.st_v1; } while (0)
#define ATT_QLOAD_N(h_, row0_) do { const bf16_t* qp_ = T.Q + (size_t)((row0_) + wid * QBLK + r32) * NQ;                              \
        _Pragma("unroll") for (int d0 = 0; d0 < 8; ++d0) S.qr[d0] = *(const bf16x8*)(qp_ + (h_) * 128 + d0 * 16 + hi * 8); } while (0)
#define ATT_QLOAD_R(h_, row0_) do { const bf16_t* qp_ = T.Q + (size_t)((row0_) + wid * QBLK + r32) * NQ;                              \
        _Pragma("unroll") for (int d0 = 0; d0 < 4; ++d0) S.qr[8 + d0] = *(const bf16x8*)(qp_ + 2048 + (h_) * 64 + d0 * 16 + hi * 8); } while (0)
#define ATT_QLOAD(h_, row0_) do { ATT_QLOAD_N(h_, row0_); ATT_QLOAD_R(h_, row0_); } while (0)

__device__ __forceinline__ void prime(const Tensors& T, int h, int qb, char* lds, Seam& S) {
    int tid = threadIdx.x; asm volatile("" : "+v"(tid));
    const int wid = __builtin_amdgcn_readfirstlane(tid >> 6), lane = tid & 63, r32 = lane & 31, hi = lane >> 5;
    char* K_lds = lds + LDS_K;
    ATT_STG_INIT();
    ATT_QLOAD(h, qb * QB);
    ATT_SLOAD(h, 0); ATT_VMW(); ATT_SWRITE_K(0);
    __syncthreads();
}
__device__ __forceinline__ void block(const Tensors& T, int h, int qb, int hn, int qbn, char* lds, Seam& S) {
    int tid = threadIdx.x; asm volatile("" : "+v"(tid));
    const int wid = __builtin_amdgcn_readfirstlane(tid >> 6), lane = tid & 63, r32 = lane & 31, hi = lane >> 5;
    const int NT = 4 * qb + 4, nact = 4 * qb + (wid >> 1) + 1;
    char* V_lds = lds; char* K_lds = lds + LDS_K;
    float* ws = (float*)(lds + LDS_WS) + wid * 64; float* li_l = ws, * al_l = ws + 32;
    float m_reg = -1e30f, l_reg = 0; f32x16 o[4] = {};
    ATT_STG_INIT();
    const int vb0 = (int)(uintptr_t)V_lds + v_rd_base(lane);
#define RESC(a) do { if (__any((a) < 1.f)) { if (hi == 0) al_l[r32] = (a); asm volatile("s_waitcnt lgkmcnt(0)" ::: "memory");              \
                     _Pragma("unroll") for (int d_ = 0; d_ < 4; ++d_) _Pragma("unroll") for (int r = 0; r < 16; ++r) o[d_][r] *= al_l[crow(r, hi)]; } } while (0)
#define ACT(t) ((t) < nact)
    f32x16 pA0, pA1, pB0, pB1; float alA, alB; bf16x8 pa0, pa1, pa2, pa3;
    char* qlds = lds + LDS_QR + wid * 4096 + lane * 16;
#pragma unroll
    for (int d0 = 0; d0 < 4; ++d0) *reinterpret_cast<bf16x8*>(qlds + d0 * 1024) = S.qr[8 + d0];
    ATT_SWRITE_V(0); SBAR();
    ATT_SLOAD(h, KVBLK);
    SBAR(); qkt<0>(pA0, pA1, K_lds, r32, hi, S.qr, qlds);
    partialSM(pA0, pA1, m_reg, alA, ACT(0));
    ATT_VMW(); ATT_SWRITE_V(1); ATT_SWRITE_K(1);
    __syncthreads();
#define HALF_STEP(PX0, PX1, alX, PY0, PY1, alY, t, KB, VB, SB) do {                                                      \
        SBAR(); if ((t) + 1 < NT) { ATT_SLOAD(h, ((t) + 1) * KVBLK); SBAR(); }                                           \
        qkt_fsm<KB>(PX0, PX1, K_lds, r32, hi, S.qr, qlds, PY0, PY1, alY, l_reg, pa0, pa1, pa2, pa3); SBAR();             \
        pv_tile<VB>(o, vb0, pa0, pa1, pa2, pa3); partialSM(PX0, PX1, m_reg, alX, ACT(t));                          \
        __syncthreads();                                                                                                  \
        if ((t) + 1 < NT) { ATT_VMW(); ATT_SWRITE_V(SB); ATT_SWRITE_K(SB); }                                             \
        RESC(alX); __syncthreads(); } while (0)
    for (int t = 1; t + 1 < NT; t += 2) {
        HALF_STEP(pB0, pB1, alB, pA0, pA1, alA, t, 1, 0, 0);
        HALF_STEP(pA0, pA1, alA, pB0, pB1, alB, t + 1, 0, 1, 1);
    }
    SBAR(); qkt<1>(pB0, pB1, K_lds, r32, hi, S.qr, qlds); SBAR();
    ATT_QLOAD_N(hn, qbn * QB); SBAR();
    finishSM(pA0, pA1, alA, l_reg, pa0, pa1, pa2, pa3); SBAR();
    pv_tile<0>(o, vb0, pa0, pa1, pa2, pa3);
    partialSM(pB0, pB1, m_reg, alB, ACT(NT - 1)); __syncthreads(); RESC(alB);
    ATT_SLOAD(hn, 0); ATT_QLOAD_R(hn, qbn * QB); SBAR();
    finishSM(pB0, pB1, alB, l_reg, pa0, pa1, pa2, pa3); SBAR(); pv_tile<1>(o, vb0, pa0, pa1, pa2, pa3);
    SBAR(); ATT_VMWN(4); ATT_SWRITE_K(0); SBAR();
    if (hi == 0) li_l[r32] = l_reg; asm volatile("s_waitcnt lgkmcnt(0)" ::: "memory");
    float rli[16];
#pragma unroll
    for (int r = 0; r < 16; ++r) rli[r] = __builtin_amdgcn_rcpf(li_l[crow(r, hi)]);
    const size_t rowb = (size_t)qb * QB + wid * QBLK;
#pragma unroll
    for (int r = 0; r < 16; ++r) { const size_t row = rowb + crow(r, hi);
        const bf16_t* gp = T.PROJ + row * PW + PJ_MGATE + h * 128 + r32; bf16_t* op = T.MIXIN + row * DM + 2048 + h * 128 + r32;
#pragma unroll
        for (int d0 = 0; d0 < 4; ++d0) { const float g = bf2f(__builtin_nontemporal_load(gp + d0 * 32)); const float v = o[d0][r] * rli[r] * (g * __builtin_amdgcn_rcpf(1.f + __builtin_amdgcn_exp2f(-1.4426950408889634f * g)));
            const float vn = __shfl_xor(v, 1);
            if ((r32 & 1) == 0) *(unsigned*)(op + d0 * 32) = cvtpk(v, vn); } }
    __syncthreads();
#undef RESC
#undef ACT
#undef HALF_STEP
}
__device__ __forceinline__ void phase(const Tensors& T, char* lds, int vcu, int G) {
    Seam S;
    const int nitems = GH * 16;
    int it = vcu; if (it >= nitems) return;
    int h = it >> 4, s = it & 15, pass = 0;
    prime(T, h, s, lds, S);
    for (;;) {
        const int qb = pass ? 31 - s : s;
        int hn = h, sn = s, passn = pass + 1, itn = it;
        const bool more_pass = pass == 0, more_item = it + G < nitems, last = !more_pass && !more_item;
        if (!more_pass) { passn = 0; itn = more_item ? it + G : it; hn = itn >> 4; sn = itn & 15; }
        const int qbn = last ? qb : (passn ? 31 - sn : sn);
        block(T, h, qb, last ? h : hn, qbn, lds, S);
        if (last) break;
        h = hn; s = sn; pass = passn; it = itn;
    }
}
#undef ATT_KOFF
#undef ATT_VMW
#undef ATT_OPQ
#undef ATT_VMWN
#undef ATT_SLOAD
#undef ATT_STG_INIT
#undef ATT_SWRITE_K
#undef ATT_SWRITE_V
#undef ATT_QLOAD
#undef ATT_QLOAD_N
#undef ATT_QLOAD_R
#undef SBAR
}


namespace glaf {
typedef float f32x16 __attribute__((ext_vector_type(16)));
__device__ __forceinline__ int crow(int r, int hi) { return (r & 3) + 8 * (r >> 2) + 4 * hi; }
typedef float f32x2_t __attribute__((ext_vector_type(2))); typedef __bf16 bf16x2_t __attribute__((ext_vector_type(2)));
__device__ __forceinline__ unsigned cvtpk(float lo, float hi) { f32x2_t v = {lo, hi}; bf16x2_t b = __builtin_convertvector(v, bf16x2_t); return __builtin_bit_cast(unsigned, b); }
__device__ __forceinline__ float log_sigmoid_f(float z) { const float t = __builtin_amdgcn_exp2f(-1.4426950408889634f * fabsf(z)); return fminf(z, 0.f) - 0.6931471805599453f * __builtin_amdgcn_logf(1.f + t); }
__device__ __forceinline__ float exp_f(float v) { return __builtin_amdgcn_exp2f(1.4426950408889634f * v); }
__device__ __forceinline__ float silu_fast(float x) { return x * __builtin_amdgcn_rcpf(1.f + __builtin_amdgcn_exp2f(-1.4426950408889634f * x)); }
template <int CTRL> __device__ __forceinline__ float dpp_add(float v) { return v + __builtin_bit_cast(float, __builtin_amdgcn_update_dpp(0, __builtin_bit_cast(int, v), CTRL, 0xf, 0xf, false)); }
__device__ __forceinline__ float row32_sum(float v) {
    v = dpp_add<0xB1>(v);
    v = dpp_add<0x4E>(v);
    v = dpp_add<0x141>(v);
    v = dpp_add<0x140>(v);
    return v + __shfl_xor(v, 16);
}
__device__ __forceinline__ int v_st(int k, int c) { const int kk = (k & ~0xC) | ((k & 4) << 1) | ((k & 8) >> 1); return ((kk >> 3) * 4 + (c >> 5)) * 512 + ((kk & 7) * 32 + (c & 31)) * 2; }
__device__ __forceinline__ int v_rd_base(int lane) { return ((lane & 3) << 3) | (((lane >> 2) & 3) << 6) | (((lane >> 4) & 1) << 5) | (((lane >> 5) & 1) << 8); }
typedef short s16x4 __attribute__((ext_vector_type(4)));
__device__ __forceinline__ void gla1(const bf16_t* __restrict__ PROJ, const float* __restrict__ THIN, const float* __restrict__ w_up, const float* __restrict__ b_alpha,
                                     bf16_t* __restrict__ KVNb, float* __restrict__ DECAY, float* ldsf, int vcu, int G) {
    int tid = threadIdx.x; asm volatile("" : "+v"(tid));
    const int wave = __builtin_amdgcn_readfirstlane(tid >> 6), lane = tid & 63, r32 = lane & 31, hi = lane >> 5;
    char* wb = (char*)ldsf + wave * 16384;
    float* wl = (float*)(wb + 8192);
    const int vb0 = (int)(uintptr_t)wb + v_rd_base(lane);
    for (int item = vcu * NWAVES + wave; item < NCH * GH; item += G * NWAVES) {
        const int n = item >> 4, h = item & 15, row0 = n * 64;
        bf16x8 kreg[8], vreg[16]; f32x4 treg[4];
#pragma unroll
        for (int i = 0; i < 8; ++i) { const int id = lane + 64 * i; kreg[i] = __builtin_nontemporal_load((const bf16x8*)(PROJ + GT_K + ((size_t)h * S + row0) * 64 + id * 8)); }
#pragma unroll
        for (int i = 0; i < 4; ++i) { const int id = lane + 64 * i; const float* tp = THIN + (size_t)(row0 + (id >> 2)) * NTHIN + (id & 3) * 4;
            treg[i] = (*(const f32x4*)tp + *(const f32x4*)(tp + (size_t)S * NTHIN)) + (*(const f32x4*)(tp + 2 * (size_t)S * NTHIN) + *(const f32x4*)(tp + 3 * (size_t)S * NTHIN)); }
        float w[16];
#pragma unroll
        for (int r = 0; r < 16; ++r) w[r] = w_up[r * 1024 + h * 64 + lane];
        const float bias = b_alpha[h * 64 + lane];
#pragma unroll
        for (int i = 0; i < 16; ++i) { const int id = lane + 64 * i; vreg[i] = __builtin_nontemporal_load((const bf16x8*)(PROJ + GT_V + ((size_t)h * S + row0) * 128 + id * 8)); }
#pragma unroll
        for (int i = 0; i < 8; ++i) *(bf16x8*)(wb + (lane + 64 * i) * 16) = kreg[i];
#pragma unroll
        for (int i = 0; i < 4; ++i) *(f32x4*)(wl + (lane + 64 * i) * 4) = treg[i];
        asm volatile("s_waitcnt lgkmcnt(0)" ::: "memory");
        float lc[64]; float cum = 0.f;
#pragma unroll
        for (int f = 0; f < 64; ++f) { float z = bias;
#pragma unroll
            for (int q = 0; q < 4; ++q) { const f32x4 a = *(const f32x4*)(wl + f * 16 + q * 4); z += a[0] * w[4 * q] + a[1] * w[4 * q + 1] + a[2] * w[4 * q + 2] + a[3] * w[4 * q + 3]; }
            cum += log_sigmoid_f(z) * (1.f / 16.f); lc[f] = cum; }
        DECAY[(size_t)item * 64 + lane] = exp_f(cum);
        const bf16_t* kl = (const bf16_t*)wb + lane;
        unsigned pk[32];
#pragma unroll
        for (int i = 0; i < 32; ++i) { const float k0 = bf2f(kl[(2 * i) * 64]) * exp_f(cum - lc[2 * i]), k1 = bf2f(kl[(2 * i + 1) * 64]) * exp_f(cum - lc[2 * i + 1]); pk[i] = cvtpk(k0, k1); }
        u32x4 fa0[4], fa1[4];
#pragma unroll
        for (int s = 0; s < 4; ++s)
#pragma unroll
            for (int i = 0; i < 4; ++i) { auto rr = __builtin_amdgcn_permlane32_swap(pk[8 * s + i], pk[8 * s + 4 + i], false, false); fa0[s][i] = rr[0]; fa1[s][i] = rr[1]; }
        asm volatile("s_waitcnt lgkmcnt(0)" ::: "memory");
#pragma unroll
        for (int i = 0; i < 16; ++i) { const int id = lane + 64 * i; *(bf16x8*)(wb + v_st(id >> 4, (id & 15) * 8)) = vreg[i]; }
        asm volatile("s_waitcnt lgkmcnt(0)" ::: "memory");
        bf16_t* op = KVNb + (size_t)item * 8192;
#define G1_TR(dst, off) asm volatile("ds_read_b64_tr_b16 %0, %1 offset:%2" : "=&v"(dst) : "v"(vb0), "i"(off) : "memory")
#define G1_B(b) do { s16x4 l0, l1, l2, l3, h0, h1, h2, h3; constexpr int b_ = (b) * 512;                                                   \
            G1_TR(l0, b_); G1_TR(h0, b_ + 2048); G1_TR(l1, b_ + 4096); G1_TR(h1, b_ + 6144); G1_TR(l2, b_ + 8192); G1_TR(h2, b_ + 10240); G1_TR(l3, b_ + 12288); G1_TR(h3, b_ + 14336); \
            asm volatile("s_waitcnt lgkmcnt(0)" ::: "memory"); __builtin_amdgcn_sched_barrier(0);                                         \
            const bf16x8 v0 = {l0[0], l0[1], l0[2], l0[3], h0[0], h0[1], h0[2], h0[3]}, v1 = {l1[0], l1[1], l1[2], l1[3], h1[0], h1[1], h1[2], h1[3]};     \
            const bf16x8 v2 = {l2[0], l2[1], l2[2], l2[3], h2[0], h2[1], h2[2], h2[3]}, v3 = {l3[0], l3[1], l3[2], l3[3], h3[0], h3[1], h3[2], h3[3]};     \
            f32x16 a0 = {}, a1 = {};                                                                                                         \
            a0 = __builtin_amdgcn_mfma_f32_32x32x16_bf16(__builtin_bit_cast(bf16x8, fa0[0]), v0, a0, 0, 0, 0); a1 = __builtin_amdgcn_mfma_f32_32x32x16_bf16(__builtin_bit_cast(bf16x8, fa1[0]), v0, a1, 0, 0, 0); \
            a0 = __builtin_amdgcn_mfma_f32_32x32x16_bf16(__builtin_bit_cast(bf16x8, fa0[1]), v1, a0, 0, 0, 0); a1 = __builtin_amdgcn_mfma_f32_32x32x16_bf16(__builtin_bit_cast(bf16x8, fa1[1]), v1, a1, 0, 0, 0); \
            a0 = __builtin_amdgcn_mfma_f32_32x32x16_bf16(__builtin_bit_cast(bf16x8, fa0[2]), v2, a0, 0, 0, 0); a1 = __builtin_amdgcn_mfma_f32_32x32x16_bf16(__builtin_bit_cast(bf16x8, fa1[2]), v2, a1, 0, 0, 0); \
            a0 = __builtin_amdgcn_mfma_f32_32x32x16_bf16(__builtin_bit_cast(bf16x8, fa0[3]), v3, a0, 0, 0, 0); a1 = __builtin_amdgcn_mfma_f32_32x32x16_bf16(__builtin_bit_cast(bf16x8, fa1[3]), v3, a1, 0, 0, 0); \
            bf16_t* orow = op + (32 * (b) + r32) * 64 + 4 * hi;                                       \
            _Pragma("unroll") for (int g_ = 0; g_ < 4; ++g_) {                                                                              \
                u32x2 w0, w1; w0.x = cvtpk(a0[4 * g_], a0[4 * g_ + 1]); w0.y = cvtpk(a0[4 * g_ + 2], a0[4 * g_ + 3]); w1.x = cvtpk(a1[4 * g_], a1[4 * g_ + 1]); w1.y = cvtpk(a1[4 * g_ + 2], a1[4 * g_ + 3]); \
                *(u32x2*)(orow + 8 * g_) = w0; *(u32x2*)(orow + 32 + 8 * g_) = w1; } } while (0)
        G1_B(0); G1_B(1); G1_B(2); G1_B(3);
#undef G1_B
#undef G1_TR
        asm volatile("s_waitcnt lgkmcnt(0)" ::: "memory");
    }
}
__device__ __forceinline__ void gla2(const bf16_t* __restrict__ KVNb, const float* __restrict__ DECAY, bf16_t* __restrict__ SN, int vcu, int G) {
    for (int e = vcu * NT + threadIdx.x; e < GH * 128 * 64; e += G * NT) {
        const int h = e / 8192, dk = e & 63;
        float st = 0.f;
#pragma unroll 16
        for (int n = 0; n < NCH; ++n) { const size_t off = (size_t)n * (GH * 8192) + e; st = DECAY[(size_t)(n * GH + h) * 64 + dk] * st + bf2f(__builtin_nontemporal_load(KVNb + off)); SN[off] = (bf16_t)f2bf(st); }
    }
}
__device__ __forceinline__ void gla3(const bf16_t* __restrict__ PROJ, const bf16_t* __restrict__ SN, const float* __restrict__ g_gla, bf16_t* __restrict__ MIXIN, float* ldsf, int vcu, int G) {
    int tid = threadIdx.x; asm volatile("" : "+v"(tid));
    const int wave = __builtin_amdgcn_readfirstlane(tid >> 6), lane = tid & 63, r32 = lane & 31, hi = lane >> 5;
    char* wb = (char*)ldsf + wave * 16384;
    for (int item = vcu * NWAVES + wave; item < NCH * GH; item += G * NWAVES) {
        const int n = item >> 4, h = item & 15, row0 = n * 64;
        bf16x8 qa[2][4], sb0[4], sb1[4]; float gl[4];
        const bf16_t* sp = SN + ((size_t)item * 128 + r32) * 64 + 8 * hi;
        { bf16x8 greg[16];
#pragma unroll
          for (int i = 0; i < 16; ++i) { const int id = lane + 64 * i; greg[i] = __builtin_nontemporal_load((const bf16x8*)(PROJ + GT_G + ((size_t)h * S + row0) * 128 + id * 8)); }
#pragma unroll
          for (int b = 0; b < 4; ++b) gl[b] = g_gla[32 * b + r32];
#pragma unroll
          for (int fb = 0; fb < 2; ++fb)
#pragma unroll
            for (int s = 0; s < 4; ++s) qa[fb][s] = __builtin_nontemporal_load((const bf16x8*)(PROJ + GT_Q + ((size_t)h * S + row0 + 32 * fb + r32) * 64 + 16 * s + 8 * hi));
#pragma unroll
          for (int s = 0; s < 4; ++s) sb0[s] = __builtin_nontemporal_load((const bf16x8*)(sp + 16 * s));
#pragma unroll
          for (int i = 0; i < 16; ++i) *(bf16x8*)(wb + (lane + 64 * i) * 16) = greg[i]; }
        __builtin_amdgcn_sched_barrier(0);
        f32x16 acc[2][4];
#define G3_MM(b, SB) do { _Pragma("unroll") for (int fb = 0; fb < 2; ++fb) { f32x16 a = {};                                                  \
            _Pragma("unroll") for (int s = 0; s < 4; ++s) a = __builtin_amdgcn_mfma_f32_32x32x16_bf16(qa[fb][s], SB[s], a, 0, 0, 0); acc[fb][b] = a; } } while (0)
#define G3_LD(b, SB) do { _Pragma("unroll") for (int s = 0; s < 4; ++s) SB[s] = __builtin_nontemporal_load((const bf16x8*)(sp + (size_t)(32 * (b)) * 64 + 16 * s)); } while (0)
        G3_LD(1, sb1); G3_MM(0, sb0); __builtin_amdgcn_sched_barrier(0);
        G3_LD(2, sb0); G3_MM(1, sb1); __builtin_amdgcn_sched_barrier(0);
        G3_LD(3, sb1); G3_MM(2, sb0); __builtin_amdgcn_sched_barrier(0);
        G3_MM(3, sb1);
#undef G3_MM
#undef G3_LD
        asm volatile("s_waitcnt lgkmcnt(0)" ::: "memory");
#pragma unroll
        for (int fb = 0; fb < 2; ++fb)
#pragma unroll
            for (int r = 0; r < 16; ++r) {
                float ss = (acc[fb][0][r] * acc[fb][0][r] + acc[fb][1][r] * acc[fb][1][r]) + (acc[fb][2][r] * acc[fb][2][r] + acc[fb][3][r] * acc[fb][3][r]);
                ss = row32_sum(ss);
                const float rstd = __builtin_amdgcn_rsqf(ss * (1.f / 128.f) + EPS);
                bf16_t* gp = (bf16_t*)(wb + (32 * fb + crow(r, hi)) * 256) + r32;
#pragma unroll
                for (int b = 0; b < 4; ++b) { const float g = bf2f(gp[32 * b]); const float v = acc[fb][b][r] * rstd * gl[b] * silu_fast(g);
                    gp[32 * b] = (bf16_t)cvtpk(v, 0.f); } }
        asm volatile("s_waitcnt lgkmcnt(0)" ::: "memory");
#pragma unroll
        for (int i = 0; i < 16; ++i) { const int id = lane + 64 * i; *(u32x4*)(MIXIN + (size_t)(row0 + (id >> 4)) * DM + h * 128 + (id & 15) * 8) = *(const u32x4*)(wb + id * 16); }
        asm volatile("s_waitcnt lgkmcnt(0)" ::: "memory");
    }
}
}


struct Args { const void* in[16]; float* out; unsigned char* ws; int ph_lo, ph_hi; };
__global__ void __launch_bounds__(NWAVES * 64, 2) mega_fwd(Args args) {
    extern __shared__ __attribute__((aligned(16))) unsigned char lds[];
    LAS unsigned char* ldsl = (LAS unsigned char*)lds;
    float* ldsf = (float*)lds;
    const int tid = threadIdx.x;
    const int G = gridDim.x; const int bx = blockIdx.x; const int vcu = (G % 8 == 0) ? (bx % 8) * (G / 8) + bx / 8 : bx;
    unsigned char* ws = args.ws;
    const float* x = (const float*)args.in[0]; const float* c = (const float*)args.in[1]; const int* pos = (const int*)args.in[2];
    const float* w_ada = (const float*)args.in[3]; const float* b_ada = (const float*)args.in[4]; const float* g_pre = (const float*)args.in[5]; const float* g_post = (const float*)args.in[6];
    const float* w_in = (const float*)args.in[7]; const float* w_up = (const float*)args.in[8]; const float* b_alpha = (const float*)args.in[9]; const float* g_gla = (const float*)args.in[10];
    const float* g_qn = (const float*)args.in[11]; const float* w_uq = (const float*)args.in[12]; const float* g_kvn = (const float*)args.in[13]; const float* w_ukv = (const float*)args.in[14]; const float* w_out = (const float*)args.in[15];
    float* out = args.out;
    float* MODP = (float*)(ws + WS_MODP); f32x2* ROPE = (f32x2*)(ws + WS_ROPE); float* SSQQ = (float*)(ws + WS_SSQQ); float* SSQKV = (float*)(ws + WS_SSQKV); float* SSQMIX = (float*)(ws + WS_SSQMIX);
    float* DECAY = (float*)(ws + WS_DECAY); float* THIN = (float*)(ws + WS_MIXIN)  ; bf16_t* KR = (bf16_t*)(ws + WS_KR);
    bf16_t* WTALL = (bf16_t*)(ws + WS_WTALL); bf16_t* WTUQ = (bf16_t*)(ws + WS_WTUQ); bf16_t* WTUKV = (bf16_t*)(ws + WS_WTUKV); bf16_t* WTOUT = (bf16_t*)(ws + WS_WTOUT);
    bf16_t* H = (bf16_t*)(ws + WS_H); bf16_t* PROJ = (bf16_t*)(ws + WS_PROJ)  ; bf16_t* GLAT = (bf16_t*)(ws + WS_PROJ + 64 * MiB); bf16_t* Q = (bf16_t*)(ws + WS_Q); bf16_t* KV = (bf16_t*)(ws + WS_KV);
    float* KVN = (float*)(ws + WS_KVN); bf16_t* SN = (bf16_t*)(ws + WS_SN); bf16_t* MIXIN = (bf16_t*)(ws + WS_MIXIN); float* MIX = (float*)(ws + WS_MIX);

    for (int u = tid; u < (LDS_BYTES - LDSCTL_OFF) / 4; u += NWAVES * 64) ((LAS unsigned*)(ldsl + LDSCTL_OFF))[u] = 0u;
    __syncthreads();
    const int lo = args.ph_lo, hi = args.ph_hi;
    unsigned* barw = (unsigned*)(ws + WS_CTL) + CW_BAR + lo * XCD_BAR_WORDS;
    XcdBarrier bar; bar.bar = barw; bar.x = 0; bar.st = nullptr;
    if (hi - lo > 1) bar = xcd_barrier_post(barw, (volatile LAS unsigned*)(ldsl + MISC_OFF) + 8);
#ifndef PH_MASK
#define PH_MASK 0xFF
#endif
#define IN(k) (((PH_MASK >> (k)) & 1) && lo <= (k) && (k) < hi)
#define GRID_BAR(k) do { if (IN(k) && IN((k) + 1)) xcd_barrier(bar); } while (0)
#ifndef REPEAT_MASK
#define REPEAT_MASK 0
#endif
#define REP(b) for (int rep_ = 0; rep_ < 1 + ((REPEAT_MASK >> (b)) & 1); ++rep_)

    if (IN(0)) REP(0) { const P0Args a{w_in, w_uq, w_ukv, w_out, g_qn, g_kvn, c, w_ada, pos, WTALL, WTUQ, WTUKV, WTOUT, MODP, ROPE}; p0_prologue(a, ldsf, vcu, G); }
    GRID_BAR(0);
    if (IN(1)) REP(1) p1_hnorm(x, g_pre, MODP, b_ada, H, ldsf, vcu, G);
    GRID_BAR(1);
    if (IN(2)) REP(2) {
        pg8::Gemm g{H, WTALL, S, NPROJ, DM, DM}; pg8::StaticOrder So; So.init(S, NPROJ, G, bx);
        pg8::EpiProjF E{PROJ, SSQQ, SSQKV, GLAT};
        pg8::gemm_phase<pg8::EpiProjF, pg8::StaticOrder, true, true>(ldsl, g, So, E);
        thin_gemm(H, WTALL + (size_t)NPROJ * DM, THIN, ldsf, vcu, G);
#ifdef PROBE_THIN2
        for (int r_ = 0; r_ < PROBE_THIN2; ++r_) thin_gemm(H, WTALL + (size_t)NPROJ * DM, THIN, ldsf, vcu, G);
#endif
    }
    GRID_BAR(2);
    if (IN(3)) {
        if (G == 256) {
            REP(3) { pg8::Gemm g{PROJ + PJ_MCQ, WTUQ, S, NQ, QRANK, PW}; pg8::SplitOrderQ So; So.init(vcu, G);
              pg8::EpiQF E{Q, SSQQ, ROPE};
              pg8::gemm_phase<pg8::EpiQF, pg8::SplitOrderQ, true, true>(ldsl, g, So, E); }
            REP(3) { pg8::Gemm g{PROJ + PJ_MCKV, WTUKV, S, NKV, KVRANK, PW}; pg8::SplitOrderKV So; So.init(vcu, G);
              pg8::EpiKVF E{KV, SSQKV};
              pg8::gemm_phase<pg8::EpiKVF, pg8::SplitOrderKV, true, true>(ldsl, g, So, E); }
        } else {
            { pg8::Gemm g{PROJ + PJ_MCQ, WTUQ, S, NQ, QRANK, PW}; pg8::StaticOrder So; So.init(S, NQ, G, bx);
              pg8::EpiQF E{Q, SSQQ, ROPE};
              pg8::gemm_phase<pg8::EpiQF, pg8::StaticOrder, true, true>(ldsl, g, So, E); }
            { pg8::Gemm g{PROJ + PJ_MCKV, WTUKV, S, NKV, KVRANK, PW}; pg8::StaticOrder So; So.init(S, NKV, G, bx);
              pg8::EpiKVF E{KV, SSQKV};
              pg8::gemm_phase<pg8::EpiKVF, pg8::StaticOrder, true, true>(ldsl, g, So, E); }
        }
        REP(4) p3_krope(THIN, ROPE, KR, vcu, G);
        REP(4) glaf::gla1(GLAT, THIN, w_up, b_alpha, (bf16_t*)KVN, DECAY, ldsf, vcu, G);
    }
    GRID_BAR(3);
    if (IN(4)) {
        REP(6) glaf::gla2((const bf16_t*)KVN, DECAY, SN, vcu, G);
        REP(5) { const att::Tensors T{Q, KV, KR, PROJ, MIXIN}; att::phase(T, (char*)lds, vcu, G); }
    }
    GRID_BAR(4);
    if (IN(5)) REP(7) glaf::gla3(GLAT, SN, g_gla, MIXIN, ldsf, vcu, G);
    GRID_BAR(5);
    if (IN(6)) REP(8) {
        pg8::Gemm g{MIXIN, WTOUT, S, DM, DM, DM}; pg8::StaticOrder So; So.init(S, DM, G, bx);
        pg8::EpiMixF E{(bf16_t*)MIX, SSQMIX};
        pg8::gemm_phase<pg8::EpiMixF, pg8::StaticOrder, true, true>(ldsl, g, So, E);
    }
    GRID_BAR(6);
    if (IN(7)) { REP(9) p7_final(x, (const bf16_t*)MIX, SSQMIX, g_post, MODP, b_ada, out, ldsf, vcu, G);
        if (hi - lo > 1 && xb_ld(&barw[XB_TMO]) != 0u) { for (int m = vcu * NWAVES + (tid >> 6); m < S; m += G * NWAVES) if ((tid & 63) == 0) out[(size_t)m * DM] = __builtin_nanf(""); } }
#undef IN
#undef GRID_BAR
}


extern "C" void kernel_launch(void* const* d_in, const int* in_sizes, int n_in, void* d_out, int out_size, void* d_ws, size_t ws_size, hipStream_t stream) {
    static int grid = 0;
    if (grid == 0) {
        if (n_in != 16 || in_sizes[0] != S * DM || out_size != S * DM || ws_size < WS_END) { fprintf(stderr, "kernel_launch: unexpected shapes (n_in %d, in0 %d, out %d, ws %zu)\n", n_in, n_in > 0 ? in_sizes[0] : -1, out_size, ws_size); grid = -1; return; }
        int dev = 0, cus = 0, per_cu = 0;
        if (hipGetDevice(&dev) != hipSuccess || hipDeviceGetAttribute(&cus, hipDeviceAttributeMultiprocessorCount, dev) != hipSuccess) { fprintf(stderr, "kernel_launch: device query failed\n"); grid = -1; return; }
        if (hipFuncSetAttribute((const void*)mega_fwd, hipFuncAttributeMaxDynamicSharedMemorySize, LDS_BYTES) != hipSuccess) { fprintf(stderr, "kernel_launch: hipFuncSetAttribute failed\n"); grid = -1; return; }
        if (hipOccupancyMaxActiveBlocksPerMultiprocessor(&per_cu, (const void*)mega_fwd, NWAVES * 64, LDS_BYTES) != hipSuccess || per_cu < 1) fprintf(stderr, "kernel_launch: note: occupancy query reports %d workgroups per CU\n", per_cu);
        (void)hipGetLastError();
        grid = cus;
    }
    if (grid < 0) return;
    (void)hipMemsetAsync((char*)d_ws + WS_CTL, 0, CTL_ZERO_BYTES, stream);
    Args a{};
    for (int i = 0; i < 16; ++i) a.in[i] = d_in[i];
    a.out = (float*)d_out; a.ws = (unsigned char*)d_ws;
    for (int p = 0; p < N_PHASES; ) { int e = p + 1; while (e < N_PHASES && !((CUT_MASK >> (e - 1)) & 1)) ++e;
        a.ph_lo = p; a.ph_hi = e; hipLaunchKernelGGL(mega_fwd, dim3(grid), dim3(NWAVES * 64), LDS_BYTES, stream, a); p = e; }
#ifdef PROBE_ATT_LAUNCH
    (void)hipFuncSetAttribute((const void*)probe_attn, hipFuncAttributeMaxDynamicSharedMemorySize, LDS_BYTES);
    hipLaunchKernelGGL(probe_attn, dim3(grid), dim3(NWAVES * 64), LDS_BYTES, stream, a);
#endif
#ifdef PROBE_PHASE
    a.ph_lo = PROBE_PHASE; a.ph_hi = PROBE_PHASE + 1; hipLaunchKernelGGL(mega_fwd, dim3(grid), dim3(NWAVES * 64), LDS_BYTES, stream, a);
#endif
    const hipError_t le = hipPeekAtLastError();
    if (le != hipSuccess) fprintf(stderr, "kernel_launch: launch failed: %s\n", hipGetErrorName(le));
}
```
